# Optimizing an MI355X kernel written in HIP

```python
import jax, jax.numpy as jnp
from jax import lax
import numpy as np

D_MODEL = 1024
BATCH = 32
SEQ = 2048
DEPTH = 1

PLE_DIM = 256
NSA_HEADS = 8
NSA_KV_GROUPS = 2
NSA_HPG = NSA_HEADS // NSA_KV_GROUPS
NSA_HEAD_DIM = 64
Q_DIM = NSA_HEADS * NSA_HEAD_DIM
KV_DIM = NSA_KV_GROUPS * NSA_HEAD_DIM
NSA_BRANCHES = 3
NSA_GATE_DIM = NSA_HEADS * NSA_BRANCHES
CMP_BLOCK = 32
CMP_STRIDE = 16
CMP_HIDDEN = 128
SEL_BLOCK = 64
SEL_TOPK = 16
SEL_Q_CHUNK = 32
WINDOW = 512
WIN_Q_BLOCK = 128
ATTN_SCALE = NSA_HEAD_DIM ** -0.5
FORCE_BONUS = 1e4
NEG_INF = -1e30
CONV_DIM = 512
CONV_WIDTH = 3
IN_PROJ_DIM = Q_DIM + 6 * KV_DIM + NSA_GATE_DIM + 3 * CONV_DIM + 2 * D_MODEL
N_GROUPS = 4
EXPERTS_PER_GROUP = 8
N_EXPERTS = N_GROUPS * EXPERTS_PER_GROUP
EXPERT_HIDDEN = 256
TOPK_EXPERTS = 2
LN_EPS = 1e-5
DEEPNORM_ALPHA = (2.0 * DEPTH) ** 0.25
DEEPNORM_BETA = (8.0 * DEPTH) ** -0.25

kernel_name = "hybrid_nsa_shortconv_hmoe_deepnorm"


def _layer_norm(x, g, b):
    xf = x.astype(jnp.float32)
    mu = jnp.mean(xf, axis=-1, keepdims=True)
    var = jnp.mean(jnp.square(xf - mu), axis=-1, keepdims=True)
    y = (xf - mu) * lax.rsqrt(var + LN_EPS) * g.astype(jnp.float32) + b.astype(jnp.float32)
    return y.astype(x.dtype)


def _compress(kv, pe, w1, b1, w2, b2):
    B, S, G, dk = kv.shape
    n_cmp = (S - CMP_BLOCK) // CMP_STRIDE + 1
    idx = np.arange(n_cmp)[:, None] * CMP_STRIDE + np.arange(CMP_BLOCK)[None, :]
    blk = kv[:, idx] + pe[:, None, :]
    blk = jnp.transpose(blk, (0, 1, 3, 2, 4)).reshape(B, n_cmp, G, CMP_BLOCK * dk)
    return jax.nn.gelu(blk @ w1 + b1) @ w2 + b2


def _compressed_attention(q, kc, vc):
    S = q.shape[1]
    n_cmp = kc.shape[1]
    t = jnp.arange(S)
    blk_end = jnp.arange(n_cmp) * CMP_STRIDE + CMP_BLOCK - 1
    mask = blk_end[None, :] <= t[:, None]
    s = jnp.einsum('bsghd,bngd->bghsn', q, kc).astype(jnp.float32) * ATTN_SCALE
    pr = jax.nn.softmax(jnp.where(mask, s, NEG_INF), axis=-1)
    pr = pr * jnp.any(mask, axis=-1)[:, None].astype(jnp.float32)
    o = jnp.einsum('bghsn,bngd->bsghd', pr.astype(vc.dtype), vc)
    return o, pr


def _select_blocks(p_cmp, S):
    n_cmp = p_cmp.shape[-1]
    n_sel = S // SEL_BLOCK
    c_start = np.arange(n_cmp) * CMP_STRIDE
    c_end = c_start + CMP_BLOCK - 1
    s_start = np.arange(n_sel) * SEL_BLOCK
    s_end = s_start + SEL_BLOCK - 1
    overlap = ((c_start[:, None] <= s_end[None, :]) & (c_end[:, None] >= s_start[None, :])).astype(np.float32)
    imp = jnp.einsum('bghsn,nm->bgsm', p_cmp, jnp.asarray(overlap))
    t = jnp.arange(S)
    j = jnp.arange(n_sel)
    cur = t // SEL_BLOCK
    valid = s_start[None, :] <= t[:, None]
    forced = (j[None, :] == 0) | (j[None, :] == cur[:, None]) | (j[None, :] == cur[:, None] - 1)
    score = jnp.where(valid, imp + FORCE_BONUS * forced.astype(jnp.float32), -FORCE_BONUS)
    _, sel_idx = lax.top_k(score, min(SEL_TOPK, n_sel))
    return sel_idx


def _selected_attention(q, k, v, sel_idx):
    B, S, G, hpg, dk = q.shape
    n_sel = S // SEL_BLOCK
    nk = sel_idx.shape[-1]
    kb = k.reshape(B, n_sel, SEL_BLOCK, G, dk).transpose(0, 3, 1, 2, 4)
    vb = v.reshape(B, n_sel, SEL_BLOCK, G, dk).transpose(0, 3, 1, 2, 4)
    nc = S // SEL_Q_CHUNK
    qc = q.reshape(B, nc, SEL_Q_CHUNK, G, hpg, dk).swapaxes(0, 1)
    ic = sel_idx.reshape(B, G, nc, SEL_Q_CHUNK, nk).transpose(2, 0, 1, 3, 4)
    tc = jnp.arange(S).reshape(nc, SEL_Q_CHUNK)
    bi = jnp.arange(B)[:, None, None, None]
    gi = jnp.arange(G)[None, :, None, None]

    def chunk(args):
        q_c, i_c, t_c = args
        kg = kb[bi, gi, i_c]
        vg = vb[bi, gi, i_c].reshape(B, G, SEL_Q_CHUNK, nk * SEL_BLOCK, dk)
        kpos = i_c[..., None] * SEL_BLOCK + jnp.arange(SEL_BLOCK)
        mask = (kpos <= t_c[None, None, :, None, None]).reshape(B, G, 1, SEL_Q_CHUNK, nk * SEL_BLOCK)
        s = jnp.einsum('bqghd,bgqnld->bghqnl', q_c, kg).astype(jnp.float32) * ATTN_SCALE
        s = s.reshape(B, G, hpg, SEL_Q_CHUNK, nk * SEL_BLOCK)
        pr = jax.nn.softmax(jnp.where(mask, s, NEG_INF), axis=-1)
        return jnp.einsum('bghqm,bgqmd->bqghd', pr.astype(vg.dtype), vg)

    out = lax.map(chunk, (qc, ic, tc))
    return out.swapaxes(0, 1).reshape(B, S, G, hpg, dk)


def _window_attention(q, k, v):
    B, S, G, hpg, dk = q.shape
    nb = S // WIN_Q_BLOCK
    band = WINDOW + WIN_Q_BLOCK
    kp = jnp.pad(k, ((0, 0), (WINDOW, 0), (0, 0), (0, 0)))
    vp = jnp.pad(v, ((0, 0), (WINDOW, 0), (0, 0), (0, 0)))
    qb = q.reshape(B, nb, WIN_Q_BLOCK, G, hpg, dk).swapaxes(0, 1)

    def block(args):
        q_b, b = args
        start = b * WIN_Q_BLOCK
        kk = lax.dynamic_slice_in_dim(kp, start, band, axis=1)
        vv = lax.dynamic_slice_in_dim(vp, start, band, axis=1)
        t = start + jnp.arange(WIN_Q_BLOCK)
        kpos = start - WINDOW + jnp.arange(band)
        d = t[:, None] - kpos[None, :]
        mask = (d >= 0) & (d < WINDOW) & (kpos[None, :] >= 0)
        s = jnp.einsum('bqghd,bkgd->bghqk', q_b, kk).astype(jnp.float32) * ATTN_SCALE
        pr = jax.nn.softmax(jnp.where(mask, s, NEG_INF), axis=-1)
        return jnp.einsum('bghqk,bkgd->bqghd', pr.astype(vv.dtype), vv)

    out = lax.map(block, (qb, jnp.arange(nb)))
    return out.swapaxes(0, 1).reshape(B, S, G, hpg, dk)


def _token_mixer(x, w_in, cmp_pe, cmp_w1, cmp_b1, cmp_w2, cmp_b2, conv_w, w_nsa_out, w_conv_out, w_o):
    B, S, _ = x.shape
    G, hpg, dk = NSA_KV_GROUPS, NSA_HPG, NSA_HEAD_DIM
    sizes = [Q_DIM] + [KV_DIM] * 6 + [NSA_GATE_DIM] + [CONV_DIM] * 3 + [D_MODEL] * 2
    z = x @ w_in
    (q, k_cmp, v_cmp, k_slc, v_slc, k_win, v_win, g_nsa,
     conv_b, conv_c, conv_h, g_m_nsa, g_m_conv) = jnp.split(z, np.cumsum(sizes)[:-1].tolist(), axis=-1)
    q = q.reshape(B, S, G, hpg, dk)
    kc = _compress(k_cmp.reshape(B, S, G, dk), cmp_pe[0], cmp_w1[0], cmp_b1[0], cmp_w2[0], cmp_b2[0])
    vc = _compress(v_cmp.reshape(B, S, G, dk), cmp_pe[1], cmp_w1[1], cmp_b1[1], cmp_w2[1], cmp_b2[1])
    o_cmp, p_cmp = _compressed_attention(q, kc, vc)
    sel_idx = _select_blocks(p_cmp, S)
    o_slc = _selected_attention(q, k_slc.reshape(B, S, G, dk), v_slc.reshape(B, S, G, dk), sel_idx)
    o_win = _window_attention(q, k_win.reshape(B, S, G, dk), v_win.reshape(B, S, G, dk))
    g = jax.nn.sigmoid(g_nsa).reshape(B, S, G, hpg, NSA_BRANCHES, 1)
    o = g[..., 0, :] * o_cmp + g[..., 1, :] * o_slc + g[..., 2, :] * o_win
    y_nsa = o.reshape(B, S, Q_DIM) @ w_nsa_out
    u = conv_c * conv_h
    uc = lax.conv_general_dilated(u, conv_w[:, None, :], window_strides=(1,),
                                  padding=[(CONV_WIDTH - 1, 0)],
                                  dimension_numbers=('NWC', 'WIO', 'NWC'),
                                  feature_group_count=CONV_DIM)
    y_conv = (conv_b * uc) @ w_conv_out
    merged = jax.nn.sigmoid(g_m_nsa) * y_nsa + jax.nn.sigmoid(g_m_conv) * y_conv
    return merged @ w_o


def _hier_moe(x, rg_w, rg_b, re_w, re_b, w_gate, w_up, w_down):
    B, S, D = x.shape
    xt = x.reshape(-1, D)
    T = xt.shape[0]
    grp_p = jax.nn.softmax((xt @ rg_w + rg_b).astype(jnp.float32), axis=-1)
    grp_top, grp_idx = lax.top_k(grp_p, 1)
    exp_logits = (xt @ re_w + re_b).astype(jnp.float32).reshape(T, N_GROUPS, EXPERTS_PER_GROUP)
    chosen = jnp.take_along_axis(exp_logits, grp_idx[:, :, None], axis=1)[:, 0]
    top_v, top_i = lax.top_k(jax.nn.softmax(chosen, axis=-1), TOPK_EXPERTS)
    top_v = top_v / jnp.sum(top_v, axis=-1, keepdims=True)
    w_grp = jnp.einsum('tk,tke->te', top_v, jax.nn.one_hot(top_i, EXPERTS_PER_GROUP, dtype=jnp.float32))
    comb = (jax.nn.one_hot(grp_idx[:, 0], N_GROUPS, dtype=jnp.float32)[:, :, None]
            * w_grp[:, None, :] * grp_top[:, :, None]).reshape(T, N_EXPERTS).astype(x.dtype)
    y = jnp.zeros_like(xt)
    for e in range(N_EXPERTS):
        h = jax.nn.silu(xt @ w_gate[e]) * (xt @ w_up[e])
        y = y + comb[:, e:e + 1] * (h @ w_down[e])
    return y.reshape(B, S, D)


def setup_inputs(seed: int = 0) -> dict:
    key = jax.random.key(seed)
    ks = jax.random.split(key, 28)
    f = jnp.float32
    L = DEPTH

    def nrm(k, shape, scale):
        return jax.random.normal(k, shape, f) * scale

    return {
        "x": nrm(ks[0], (BATCH, SEQ, D_MODEL), 1.0),
        "p": nrm(ks[1], (DEPTH, BATCH, SEQ, PLE_DIM), 1.0),
        "w_in": nrm(ks[2], (L, D_MODEL, IN_PROJ_DIM), D_MODEL ** -0.5),
        "cmp_pe": nrm(ks[3], (L, 2, CMP_BLOCK, NSA_HEAD_DIM), 0.1),
        "cmp_w1": nrm(ks[4], (L, 2, CMP_BLOCK * NSA_HEAD_DIM, CMP_HIDDEN), (CMP_BLOCK * NSA_HEAD_DIM) ** -0.5),
        "cmp_b1": nrm(ks[5], (L, 2, CMP_HIDDEN), 0.01),
        "cmp_w2": nrm(ks[6], (L, 2, CMP_HIDDEN, NSA_HEAD_DIM), CMP_HIDDEN ** -0.5),
        "cmp_b2": nrm(ks[7], (L, 2, NSA_HEAD_DIM), 0.01),
        "conv_w": nrm(ks[8], (L, CONV_WIDTH, CONV_DIM), CONV_WIDTH ** -0.5),
        "w_nsa_out": nrm(ks[9], (L, Q_DIM, D_MODEL), Q_DIM ** -0.5),
        "w_conv_out": nrm(ks[10], (L, CONV_DIM, D_MODEL), CONV_DIM ** -0.5),
        "w_o": nrm(ks[11], (L, D_MODEL, D_MODEL), D_MODEL ** -0.5 * DEEPNORM_BETA),
        "ln1_g": 1.0 + nrm(ks[12], (L, D_MODEL), 0.02),
        "ln1_b": nrm(ks[13], (L, D_MODEL), 0.02),
        "router_group_w": nrm(ks[14], (L, D_MODEL, N_GROUPS), D_MODEL ** -0.5),
        "router_group_b": nrm(ks[15], (L, N_GROUPS), 0.01),
        "router_expert_w": nrm(ks[16], (L, D_MODEL, N_EXPERTS), D_MODEL ** -0.5),
        "router_expert_b": nrm(ks[17], (L, N_EXPERTS), 0.01),
        "expert_w_gate": nrm(ks[18], (L, N_EXPERTS, D_MODEL, EXPERT_HIDDEN), D_MODEL ** -0.5),
        "expert_w_up": nrm(ks[19], (L, N_EXPERTS, D_MODEL, EXPERT_HIDDEN), D_MODEL ** -0.5),
        "expert_w_down": nrm(ks[20], (L, N_EXPERTS, EXPERT_HIDDEN, D_MODEL), EXPERT_HIDDEN ** -0.5 * DEEPNORM_BETA),
        "ple_proj": nrm(ks[21], (L, PLE_DIM, D_MODEL), PLE_DIM ** -0.5),
        "ple_gate_w": nrm(ks[22], (L, D_MODEL, D_MODEL), D_MODEL ** -0.5),
        "ple_gate_b": nrm(ks[23], (L, D_MODEL), 0.01),
        "ln2_g": 1.0 + nrm(ks[24], (L, D_MODEL), 0.02),
        "ln2_b": nrm(ks[25], (L, D_MODEL), 0.02),
    }


def reference(x, p, w_in, cmp_pe, cmp_w1, cmp_b1, cmp_w2, cmp_b2, conv_w, w_nsa_out, w_conv_out, w_o,
              ln1_g, ln1_b, router_group_w, router_group_b, router_expert_w, router_expert_b,
              expert_w_gate, expert_w_up, expert_w_down, ple_proj, ple_gate_w, ple_gate_b, ln2_g, ln2_b):
    for i in range(DEPTH):
        mix = _token_mixer(x, w_in[i], cmp_pe[i], cmp_w1[i], cmp_b1[i], cmp_w2[i], cmp_b2[i],
                           conv_w[i], w_nsa_out[i], w_conv_out[i], w_o[i])
        x = _layer_norm(DEEPNORM_ALPHA * x + mix, ln1_g[i], ln1_b[i])
        ffn = _hier_moe(x, router_group_w[i], router_group_b[i], router_expert_w[i], router_expert_b[i],
                        expert_w_gate[i], expert_w_up[i], expert_w_down[i])
        ple = jax.nn.sigmoid(x @ ple_gate_w[i] + ple_gate_b[i]) * (p[i] @ ple_proj[i])
        x = _layer_norm(DEEPNORM_ALPHA * x + ffn + ple, ln2_g[i], ln2_b[i])
    return x
```

```cpp
#include <hip/hip_runtime.h>
#include <cstdio>
#include <cstdint>
#include <type_traits>

#define LAS __attribute__((address_space(3)))
#define GAS __attribute__((address_space(1)))
typedef unsigned short bf16_t;
typedef short bf16x8 __attribute__((ext_vector_type(8)));
typedef float f32x4 __attribute__((ext_vector_type(4)));
typedef float f32x2 __attribute__((ext_vector_type(2)));
typedef unsigned u32x4 __attribute__((ext_vector_type(4)));
typedef unsigned u32x2 __attribute__((ext_vector_type(2)));
typedef __bf16 bf16x2_t __attribute__((ext_vector_type(2)));
typedef int i32x4 __attribute__((ext_vector_type(4)));
typedef int i32x8 __attribute__((ext_vector_type(8)));
typedef GAS unsigned gu32;
#define RLX_AGENT __ATOMIC_RELAXED, __HIP_MEMORY_SCOPE_AGENT
#define LDS_WAIT() asm volatile("s_waitcnt lgkmcnt(0)" ::: "memory")
#define VM_WAIT() asm volatile("s_waitcnt vmcnt(0)" ::: "memory")

constexpr int BATCH = 32, SEQ = 2048, DM = 1024, M = BATCH * SEQ, PLE = 256;
constexpr int NZP = 5120, NZ = 4888;
constexpr int NHM = 1280;
constexpr int HS_Q = 0, HS_KC = 8, HS_VC = 10, HS_KS = 12, HS_VS = 14, HS_KW = 16, HS_VW = 18;
constexpr int NZB = 1536;
constexpr int ZP = 1088;
constexpr int C_CB = 0, C_U = 512, C_GN = 1024;
constexpr int ZGP = 2048, C_GMN = 0, C_GMC = 1024;
__host__ __device__ __forceinline__ size_t zg_off(int row, int col) { return ((size_t)(row >> 3) * (ZGP / 64) + (size_t)(col >> 6)) * 512 + (size_t)((row & 7) * 64 + (col & 63)); }
constexpr int NEXP = 32, EH = 256;
constexpr float LN_EPS = 1e-5f;
constexpr float ALPHA = 1.189207115002721f;
constexpr float C2 = 0.125f * 1.4426950408889634f;

constexpr size_t MiB = 1u << 20;
constexpr size_t WS_CTL = 0, CTL_ZERO_BYTES = 1 * MiB;
constexpr size_t WS_B1F = 1 * MiB;
constexpr size_t WS_CNT = 1 * MiB + 4096;
constexpr size_t WS_META = 1 * MiB + 4096 + 65536;
constexpr size_t WS_ROUTE = 2 * MiB;
constexpr size_t WS_TOKSLOT = 3 * MiB;
constexpr size_t WS_WSLOT = 3 * MiB + 512 * 1024;
constexpr size_t WS_PERM = 6 * MiB;
constexpr size_t WS_KC = 4 * MiB, WS_VC = 5 * MiB;
constexpr size_t WS_WI = 8 * MiB, WS_WN = 18 * MiB, WS_WC = 19 * MiB, WS_WO = 20 * MiB, WS_WPG = 22 * MiB, WS_WPP = 24 * MiB, WS_W1 = 25 * MiB, WS_W2 = 26 * MiB, WS_WGU = 28 * MiB, WS_WD = 60 * MiB;
constexpr size_t WS_WRH = 26 * MiB + 256 * 1024, WS_WRL = 26 * MiB + 512 * 1024;
constexpr size_t WS_PB = 76 * MiB;
constexpr size_t WS_Z = 108 * MiB;
constexpr size_t WS_ZG8 = 332 * MiB;
constexpr size_t WS_T1 = 460 * MiB;
constexpr size_t WS_HM = 588 * MiB;
constexpr size_t WS_X1B = 108 * MiB, WS_XS = 236 * MiB, WS_PLE = 494 * MiB;
constexpr size_t WS_XB = 748 * MiB;
constexpr size_t WS_OV = 876 * MiB;
constexpr size_t WS_YS = 748 * MiB;
constexpr size_t WS_END = 1005 * MiB;

constexpr int LDS_MISC = 0;
constexpr int RING_OFF = 1024;
constexpr int LDS_BYTES = 147456;
constexpr int NWAVES = 8;

__device__ __forceinline__ int lane_id() { int l; asm volatile("v_mbcnt_lo_u32_b32 %0, -1, 0\n\tv_mbcnt_hi_u32_b32 %0, -1, %0" : "=v"(l)); return l; }
__device__ __forceinline__ unsigned cvtpk(float lo, float hi) { f32x2 v = {lo, hi}; bf16x2_t b = __builtin_convertvector(v, bf16x2_t); return __builtin_bit_cast(unsigned, b); }
__device__ __forceinline__ int pack4_fp8(float a, float b, float c, float d) { int r = __builtin_amdgcn_cvt_pk_fp8_f32(a, b, 0, false); return __builtin_amdgcn_cvt_pk_fp8_f32(c, d, r, true); }
__device__ __forceinline__ void unpack8_fp8(const u32x2& w, f32x4& a, f32x4& b) { const f32x2 a0 = __builtin_amdgcn_cvt_pk_f32_fp8((int)w.x, false), a1 = __builtin_amdgcn_cvt_pk_f32_fp8((int)w.x, true), b0 = __builtin_amdgcn_cvt_pk_f32_fp8((int)w.y, false), b1 = __builtin_amdgcn_cvt_pk_f32_fp8((int)w.y, true);
    a = (f32x4){a0[0], a0[1], a1[0], a1[1]}; b = (f32x4){b0[0], b0[1], b1[0], b1[1]}; }
__device__ __forceinline__ float bflo(unsigned u) { return __uint_as_float(u << 16); }
__device__ __forceinline__ float bfhi(unsigned u) { return __uint_as_float(u & 0xffff0000u); }
__device__ __forceinline__ float sigm(float x) { return __builtin_amdgcn_rcpf(1.0f + __expf(-x)); }
__device__ __forceinline__ u32x4 pack8(const f32x4& a, const f32x4& b) { u32x4 w; w.x = cvtpk(a[0], a[1]); w.y = cvtpk(a[2], a[3]); w.z = cvtpk(b[0], b[1]); w.w = cvtpk(b[2], b[3]); return w; }
__device__ __forceinline__ void unpack8(const u32x4& w, f32x4& a, f32x4& b) { a = (f32x4){bflo(w.x), bfhi(w.x), bflo(w.y), bfhi(w.y)}; b = (f32x4){bflo(w.z), bfhi(w.z), bflo(w.w), bfhi(w.w)}; }

namespace pg8 {
constexpr int BM = 256, BK = 64, HALF = 128, HTB = HALF * BK * 2, STAGE_BYTES = 8 * HTB, NXCD = 8, WGM = 8;
__host__ __device__ __forceinline__ int lds_swz(int r) { return r & 7; }
__host__ __device__ __forceinline__ int lds_byte(int r, int c) { return r * 128 + (((c >> 3) ^ lds_swz(r)) << 4) + (c & 7) * 2; }
__host__ __device__ __forceinline__ void stage_rc(int b, int& R, int& C) { R = b >> 7; C = ((((b >> 4) & 7) ^ lds_swz(R)) << 3); }
__host__ __device__ __forceinline__ int perm32(int rho) { const int n = rho >> 4, i = rho & 15; return 8 * (i >> 2) + 4 * n + (i & 3); }

struct Unit { int arow, brow, orow, ocol, nvalid, idx; };
struct Gemm { const bf16_t* A; const bf16_t* Bt; int lda, ldb, K; };

struct GridOrder {
    int nM, nN, nwg, G, c;
    __device__ void init(int M_, int N_, int G_, int c_) { nM = M_ / BM; nN = N_ / BM; nwg = nM * nN; G = G_; c = c_; }
    __device__ __forceinline__ bool next(int i, Unit& u) const {
        const long L = (long)i * G + c; if (L >= nwg) return false;
        int wgid = (int)L; { const int q = nwg / NXCD, r = nwg % NXCD, xcd = wgid % NXCD, off = wgid / NXCD; wgid = (xcd < r ? xcd * (q + 1) : r * (q + 1) + (xcd - r) * q) + off; }
        const int nig = WGM * nN, gid = wgid / nig, fm = gid * WGM, gsz = (nM - fm) < WGM ? (nM - fm) : WGM;
        const int pm = fm + ((wgid % nig) % gsz), pn = (wgid % nig) / gsz;
        u.arow = pm * BM; u.brow = pn * BM; u.orow = pm * BM; u.ocol = pn * BM; u.nvalid = BM; u.idx = i; return true;
    }
};

__device__ __forceinline__ void pg8_dma(const void* sbase_, unsigned voff, unsigned lds_dst) { unsigned keep;
    const unsigned long long sb_ = (unsigned long long)sbase_;
    const unsigned long long sbase = ((unsigned long long)(unsigned)__builtin_amdgcn_readfirstlane((int)(sb_ >> 32)) << 32) | (unsigned)__builtin_amdgcn_readfirstlane((int)sb_);
    asm volatile("s_mov_b32 %0, m0\n\ts_mov_b32 m0, %3\n\ts_nop 0\n\tglobal_load_lds_dwordx4 %1, %2\n\ts_mov_b32 m0, %0" : "=&s"(keep) : "v"(voff), "s"(sbase), "s"(lds_dst) : "memory"); }
__device__ __forceinline__ i32x8 pg8_cat(i32x4 a, i32x4 b) { return __builtin_shufflevector(a, b, 0, 1, 2, 3, 4, 5, 6, 7); }
template <class T> __device__ __forceinline__ T pg8_ld16(const LAS unsigned char* p);
template <> __device__ __forceinline__ bf16x8 pg8_ld16<bf16x8>(const LAS unsigned char* p) { return *(const LAS bf16x8*)p; }
template <> __device__ __forceinline__ i32x8 pg8_ld16<i32x8>(const LAS unsigned char* p) { (void)p; return i32x8{}; }
__device__ __forceinline__ f32x4 pg8_mma16(bf16x8 w, bf16x8 x, f32x4 c) { return __builtin_amdgcn_mfma_f32_16x16x32_bf16(w, x, c, 0, 0, 0); }
__device__ __forceinline__ f32x4 pg8_mma16(i32x8, i32x8, f32x4 c) { return c; }
__device__ __forceinline__ f32x4 pg8_mma8(i32x8 w, i32x8 x, f32x4 c) { return __builtin_amdgcn_mfma_scale_f32_16x16x128_f8f6f4(w, x, c, 0, 0, 0, 0x7a7a7a7a, 0, 0x7f7f7f7f); }
__device__ __forceinline__ f32x4 pg8_mma8(bf16x8, bf16x8, f32x4 c) { return c; }
template <class Epi, class Sched, bool GATHER = false, bool MIDK = false, bool FP8 = false>
__device__ __forceinline__ void gemm_phase(LAS unsigned char* lds, const Gemm g, const Sched& S, const Epi& E, int wave_, const LAS unsigned* tab = nullptr) {
    int lane = lane_id(); asm volatile("" : "+v"(lane));
    const int wid = wave_, tid = wid * 64 + lane, wr = wid >> 2, wc = wid & 3, fr = lane & 15, fq = lane >> 4;
    const int K = g.K, nt = K / BK;
    unsigned voffA[2], voffB[2], tabA[2];
#pragma unroll
    for (int i = 0; i < 2; ++i) { int R, C; stage_rc(tid * 16 + i * 8192, R, C); const int Rb = (R & ~31) + perm32(R & 31);
        voffA[i] = GATHER ? (unsigned)C * 2u : (unsigned)(R * g.lda + C) * 2u; tabA[i] = (unsigned)R; voffB[i] = (unsigned)(Rb * g.ldb + C) * 2u; }
    const size_t kstep = (size_t)(BK * 2);
    const size_t hstepA = (size_t)HALF * g.lda * 2, hstepB = (size_t)HALF * g.ldb * 2;
    const unsigned ldsw = (unsigned)wid * 1024u; const unsigned lds32 = (unsigned)(size_t)lds + ldsw;
    const int aoff = lds_byte(wr * 64 + fr, fq * 8), boff = (wc >> 1) * HTB + lds_byte((wc & 1) * 64 + fr, fq * 8);
    const int aoff1 = lds_byte(wr * 64 + fr, 32 + fq * 8), boff1 = (wc >> 1) * HTB + lds_byte((wc & 1) * 64 + fr, 32 + fq * 8);
    LAS unsigned char* ldsA = lds + aoff; LAS unsigned char* ldsB = lds + 4 * HTB + boff; LAS unsigned char* ldsA1 = lds + aoff1; LAS unsigned char* ldsB1 = lds + 4 * HTB + boff1;
    asm volatile("" : "+v"(ldsA), "+v"(ldsB), "+v"(ldsA1), "+v"(ldsB1));
#define PG8_SA(b, h) (((b) * 2 + (h)) * HTB)
#define PG8_SB(b, h) ((4 + (b) * 2 + (h)) * HTB)
#define PG8_STAGE(bufoff, gbase, voff) do { _Pragma("unroll") for (int _i = 0; _i < 2; ++_i) \
        pg8_dma((const char*)(gbase), (voff)[_i], lds32 + (unsigned)((bufoff) + _i * 8192)); } while (0)
#define PG8_STAGE_A(bufoff, h, nx, koff) do { if (GATHER) { _Pragma("unroll") for (int _i = 0; _i < 2; ++_i) { const unsigned ro_ = tab[(ui + (nx)) * 256 + (h) * HALF + tabA[_i]]; \
        pg8_dma((const char*)g.A + (size_t)(koff), ro_ + voffA[_i], lds32 + (unsigned)((bufoff) + _i * 8192)); } } \
        else { PG8_STAGE(bufoff, ((nx) ? nA : cA) + (size_t)(h) * hstepA + (koff), voffA); } } while (0)
#define PG8_LDA(dst, b, h) do { _Pragma("unroll") for (int m = 0; m < 4; ++m) { if constexpr (FP8) { const i32x4 l0_ = *(const LAS i32x4*)(ldsA + PG8_SA(b, h) + m * 2048), l1_ = *(const LAS i32x4*)(ldsA1 + PG8_SA(b, h) + m * 2048); \
            dst[m][0] = pg8_cat(l0_, l1_); } else { _Pragma("unroll") for (int k = 0; k < 2; ++k) dst[m][k] = pg8_ld16<frag_t>((k ? ldsA1 : ldsA) + PG8_SA(b, h) + m * 2048); } } } while (0)
#define PG8_LDB(dst, b, h) do { _Pragma("unroll") for (int n = 0; n < 2; ++n) { if constexpr (FP8) { const i32x4 l0_ = *(const LAS i32x4*)(ldsB + (PG8_SB(b, 0) - 4 * HTB) + (h) * 4096 + n * 2048), l1_ = *(const LAS i32x4*)(ldsB1 + (PG8_SB(b, 0) - 4 * HTB) + (h) * 4096 + n * 2048); \
            dst[n][0] = pg8_cat(l0_, l1_); } else { _Pragma("unroll") for (int k = 0; k < 2; ++k) dst[n][k] = pg8_ld16<frag_t>((k ? ldsB1 : ldsB) + (PG8_SB(b, 0) - 4 * HTB) + (h) * 4096 + n * 2048); } } } while (0)
#define PG8_MMA(ai, bj, At, Bt) do { if constexpr (FP8) __builtin_amdgcn_sched_barrier(0);     \
        __builtin_amdgcn_s_setprio(1); \
        _Pragma("unroll") for (int m = 0; m < 4; ++m) _Pragma("unroll") for (int n = 0; n < 2; ++n) { \
            if constexpr (FP8) acc[ai][bj][m][n] = pg8_mma8(Bt[n][0], At[m][0], acc[ai][bj][m][n]); \
            else { _Pragma("unroll") for (int k = 0; k < 2; ++k) acc[ai][bj][m][n] = pg8_mma16(Bt[n][k], At[m][k], acc[ai][bj][m][n]); } } \
        __builtin_amdgcn_s_setprio(0); \
        if constexpr (FP8) { asm volatile("" : "+v"(acc[ai][bj][0][0]), "+v"(acc[ai][bj][0][1]), "+v"(acc[ai][bj][1][0]), "+v"(acc[ai][bj][1][1]), "+v"(acc[ai][bj][2][0]), "+v"(acc[ai][bj][2][1]), "+v"(acc[ai][bj][3][0]), "+v"(acc[ai][bj][3][1])); \
            __builtin_amdgcn_sched_barrier(0); } } while (0)
#define PG8_WAIT_V(n) asm volatile("s_waitcnt vmcnt(" #n ")" ::: "memory")
#define PG8_WAIT_L(n) asm volatile("s_waitcnt lgkmcnt(" #n ")" ::: "memory")
#define PG8_BAR __builtin_amdgcn_s_barrier()
#define PG8_SCHED __builtin_amdgcn_sched_barrier(0)
    Unit cur, nxt; int ui = 0;
    if (!S.next(0, cur)) return;
    f32x4 acc[2][2][4][2];
#pragma unroll
    for (int a = 0; a < 2; ++a)
#pragma unroll
        for (int b = 0; b < 2; ++b)
#pragma unroll
            for (int m = 0; m < 4; ++m)
#pragma unroll
                for (int n = 0; n < 2; ++n) acc[a][b][m][n] = (f32x4){0.f, 0.f, 0.f, 0.f};
    typedef typename std::conditional<FP8, i32x8, bf16x8>::type frag_t;
    frag_t At[4][FP8 ? 1 : 2], B0[2][FP8 ? 1 : 2], B1[2][FP8 ? 1 : 2];
    const char* cA = (const char*)g.A + (size_t)cur.arow * g.lda * 2; const char* cB = (const char*)g.Bt + (size_t)cur.brow * g.ldb * 2;
    const char* nA = cA;
    PG8_STAGE(PG8_SB(0, 0), cB, voffB); PG8_STAGE(PG8_SB(0, 1), cB + hstepB, voffB); PG8_STAGE_A(PG8_SA(0, 0), 0, 0, 0); PG8_STAGE_A(PG8_SA(0, 1), 1, 0, 0);
    if (wr == 1) PG8_BAR;
    PG8_WAIT_V(2); PG8_BAR;
    PG8_STAGE(PG8_SB(1, 0), cB + kstep, voffB); PG8_STAGE_A(PG8_SA(1, 0), 0, 0, kstep); PG8_STAGE(PG8_SB(1, 1), cB + hstepB + kstep, voffB);
    if constexpr (Epi::ST16 && !FP8 && !MIDK) PG8_WAIT_V(0); else PG8_WAIT_V(6);
    PG8_BAR;
    for (;;) {
        const bool has_next = S.next(ui + 1, nxt);
        nA = has_next ? (const char*)g.A + (size_t)nxt.arow * g.lda * 2 : cA; const char* nB = has_next ? (const char*)g.Bt + (size_t)nxt.brow * g.ldb * 2 : cB;
        const int nxu = has_next ? 1 : 0;
#define PG8_KPAIR(WV12) do { \
            if constexpr (MIDK) { if (t == (nt >> 1)) { const int le_ = lane_id(); E.mid(acc, cur, wr, wc, le_ & 15, le_ >> 4); } }        \
            const bool last = (t == nt - 2); \
            const size_t k1 = (size_t)(t + 1) * kstep, k2 = last ? 0 : (size_t)(t + 2) * kstep, k3 = k2 + kstep; const int nx2 = last ? nxu : 0; \
            const char* b2 = last ? nB : cB + (size_t)(t + 2) * kstep; const char* b3 = b2 + kstep; \
            PG8_LDB(B0, 0, 0); PG8_LDB(B1, 0, 1); PG8_SCHED; PG8_LDA(At, 0, 0); PG8_STAGE_A(PG8_SA(1, 1), 1, 0, k1); \
            WV12; PG8_WAIT_L(0); PG8_BAR; PG8_MMA(0, 0, At, B0); PG8_MMA(0, 1, At, B1); PG8_BAR; PG8_SCHED; \
            PG8_LDA(At, 0, 1); PG8_STAGE(PG8_SB(0, 0), b2, voffB); PG8_STAGE(PG8_SB(0, 1), b2 + hstepB, voffB); PG8_STAGE_A(PG8_SA(0, 0), 0, nx2, k2); \
            WV12; PG8_WAIT_L(0); PG8_BAR; PG8_MMA(1, 0, At, B0); PG8_MMA(1, 1, At, B1); PG8_BAR; PG8_SCHED; \
            PG8_LDB(B0, 1, 0); PG8_LDB(B1, 1, 1); PG8_SCHED; PG8_LDA(At, 1, 0); PG8_STAGE_A(PG8_SA(0, 1), 1, nx2, k2); \
            PG8_WAIT_V(8); PG8_WAIT_L(0); PG8_BAR; PG8_MMA(0, 0, At, B0); PG8_MMA(0, 1, At, B1); PG8_BAR; PG8_SCHED; \
            PG8_LDA(At, 1, 1); PG8_STAGE(PG8_SB(1, 0), b3, voffB); PG8_STAGE(PG8_SB(1, 1), b3 + hstepB, voffB); PG8_STAGE_A(PG8_SA(1, 0), 0, nx2, k3); \
            PG8_WAIT_V(8); PG8_WAIT_L(0); PG8_BAR; PG8_MMA(1, 0, At, B0); PG8_MMA(1, 1, At, B1); PG8_BAR; PG8_SCHED; } while (0)
        int t = 0;
        if constexpr (Epi::ST16 && !FP8 && !MIDK) { if (nt >= 4) { PG8_KPAIR(PG8_WAIT_V(24)); t = 2; } }
        for (; t < nt; t += 2) PG8_KPAIR(PG8_WAIT_V(8));
#undef PG8_KPAIR
        if (wr == 0) PG8_BAR;
        { const int le_ = lane_id(); E(acc, cur, wr, wc, le_ & 15, le_ >> 4); }
        if (!has_next) break;
#pragma unroll
        for (int a = 0; a < 2; ++a)
#pragma unroll
            for (int b = 0; b < 2; ++b)
#pragma unroll
                for (int m = 0; m < 4; ++m)
#pragma unroll
                    for (int n = 0; n < 2; ++n) acc[a][b][m][n] = (f32x4){0.f, 0.f, 0.f, 0.f};
        cur = nxt; cA = nA; cB = nB; ++ui;
        if (wr == 1) PG8_BAR;
    }
    PG8_WAIT_V(0);
    PG8_BAR;
#undef PG8_SA
#undef PG8_SB
#undef PG8_STAGE
#undef PG8_STAGE_A
#undef PG8_LDA
#undef PG8_LDB
#undef PG8_MMA
#undef PG8_WAIT_V
#undef PG8_WAIT_L
#undef PG8_BAR
#undef PG8_SCHED
}

#define EPI_LOOP_BEGIN \
    _Pragma("unroll") for (int ai = 0; ai < 2; ++ai) _Pragma("unroll") for (int m = 0; m < 4; ++m) { const int rloc = ai * HALF + wr * 64 + m * 16 + fr; \
    _Pragma("unroll") for (int bj = 0; bj < 2; ++bj) { const int cloc = wc * 64 + bj * 32 + 8 * fq; const f32x4 v0 = acc[ai][bj][m][0], v1 = acc[ai][bj][m][1];
#define EPI_LOOP_END } }

__device__ __forceinline__ unsigned epi_ror8(unsigned v) { return (unsigned)__builtin_amdgcn_update_dpp(0, (int)v, 0x128, 0xf, 0xf, true); }
__device__ __forceinline__ void epi_xch(bool lo, const u32x4& A, const u32x4& B, u32x4& d1, u32x4& d2) { const u32x4 snd = lo ? B : A; u32x4 rcv; rcv.x = epi_ror8(snd.x); rcv.y = epi_ror8(snd.y); rcv.z = epi_ror8(snd.z); rcv.w = epi_ror8(snd.w); d1 = lo ? A : rcv; d2 = lo ? rcv : B; }
__device__ __forceinline__ void epi_xch(bool lo, const u32x2& A, const u32x2& B, u32x2& d1, u32x2& d2) { const u32x2 snd = lo ? B : A; u32x2 rcv; rcv.x = epi_ror8(snd.x); rcv.y = epi_ror8(snd.y); d1 = lo ? A : rcv; d2 = lo ? rcv : B; }
__device__ __forceinline__ void epi_xch(bool lo, unsigned A, unsigned B, unsigned& d1, unsigned& d2) { const unsigned rcv = epi_ror8(lo ? B : A); d1 = lo ? A : rcv; d2 = lo ? rcv : B; }
#define EPI_BLK_BEGIN const bool lo_ = fr < 8; const int r7_ = fr & 7, cx_ = wc * 64 + 8 * fq + (lo_ ? 0 : 32); (void)r7_; (void)cx_; \
    _Pragma("unroll") for (int ai = 0; ai < 2; ++ai) _Pragma("unroll") for (int m = 0; m < 4; ++m) { const int rb_ = ai * HALF + wr * 64 + m * 16; (void)rb_;
#define EPI_BLK_END }

struct EpiStoreBf16 { static constexpr bool ST16 = true;
    bf16_t* O; int ld;
    __device__ __forceinline__ void operator()(const f32x4 (&acc)[2][2][4][2], const Unit& u, int wr, int wc, int fr, int fq) const {
        EPI_BLK_BEGIN
            u32x4 d1, d2; epi_xch(lo_, pack8(acc[ai][0][m][0], acc[ai][0][m][1]), pack8(acc[ai][1][m][0], acc[ai][1][m][1]), d1, d2);
            bf16_t* p = O + (size_t)(u.orow + rb_ + r7_) * ld + u.ocol + cx_; *(u32x4*)p = d1; *(u32x4*)(p + (size_t)8 * ld) = d2;
        EPI_BLK_END
    }
};
struct EpiStoreFp8 { static constexpr bool ST16 = true;
    unsigned char* O8;
    __device__ __forceinline__ void operator()(const f32x4 (&acc)[2][2][4][2], const Unit& u, int wr, int wc, int fr, int fq) const {
        EPI_BLK_BEGIN
            u32x2 a8, b8, d1, d2;
            a8.x = (unsigned)pack4_fp8(acc[ai][0][m][0][0], acc[ai][0][m][0][1], acc[ai][0][m][0][2], acc[ai][0][m][0][3]); a8.y = (unsigned)pack4_fp8(acc[ai][0][m][1][0], acc[ai][0][m][1][1], acc[ai][0][m][1][2], acc[ai][0][m][1][3]);
            b8.x = (unsigned)pack4_fp8(acc[ai][1][m][0][0], acc[ai][1][m][0][1], acc[ai][1][m][0][2], acc[ai][1][m][0][3]); b8.y = (unsigned)pack4_fp8(acc[ai][1][m][1][0], acc[ai][1][m][1][1], acc[ai][1][m][1][2], acc[ai][1][m][1][3]);
            epi_xch(lo_, a8, b8, d1, d2);
            unsigned char* p = O8 + (size_t)(u.orow + rb_ + r7_) * DM + u.ocol + cx_; *(u32x2*)p = d1; *(u32x2*)(p + (size_t)8 * DM) = d2;
        EPI_BLK_END
    }
};
struct EpiInProj8 { static constexpr bool ST16 = true;
    bf16_t* HM; unsigned char* ZG; bf16_t* Zp;
    __device__ __forceinline__ void operator()(const f32x4 (&acc)[2][2][4][2], const Unit& u, int wr, int wc, int fr, int fq) const {
        if (u.ocol >= NHM + ZGP) {
            EPI_LOOP_BEGIN
                const int zc = u.ocol - (NHM + ZGP) + cloc;
                if (zc < 24) *(u32x4*)(Zp + (size_t)(u.orow + rloc) * ZP + C_GN + zc) = pack8(v0, v1);
            EPI_LOOP_END
        } else if (u.ocol < NHM) {
            EPI_BLK_BEGIN
                u32x4 d1, d2; epi_xch(lo_, pack8(acc[ai][0][m][0], acc[ai][0][m][1]), pack8(acc[ai][1][m][0], acc[ai][1][m][1]), d1, d2);
                const int row = u.orow + rb_ + r7_, col = u.ocol + cx_;
                bf16_t* p = HM + ((size_t)((col >> 6) * BATCH + (row >> 11)) * SEQ + (row & (SEQ - 1))) * 64 + (col & 63); *(u32x4*)p = d1; *(u32x4*)(p + 8 * 64) = d2;
            EPI_BLK_END
        } else {
            EPI_BLK_BEGIN
                u32x2 a8, b8, d1, d2;
                a8.x = (unsigned)pack4_fp8(acc[ai][0][m][0][0], acc[ai][0][m][0][1], acc[ai][0][m][0][2], acc[ai][0][m][0][3]); a8.y = (unsigned)pack4_fp8(acc[ai][0][m][1][0], acc[ai][0][m][1][1], acc[ai][0][m][1][2], acc[ai][0][m][1][3]);
                b8.x = (unsigned)pack4_fp8(acc[ai][1][m][0][0], acc[ai][1][m][0][1], acc[ai][1][m][0][2], acc[ai][1][m][0][3]); b8.y = (unsigned)pack4_fp8(acc[ai][1][m][1][0], acc[ai][1][m][1][1], acc[ai][1][m][1][2], acc[ai][1][m][1][3]);
                epi_xch(lo_, a8, b8, d1, d2);
                unsigned char* p = ZG + zg_off(u.orow + rb_ + r7_, (u.ocol - NHM) + cx_); *(u32x2*)p = d1; *(u32x2*)(p + (size_t)(ZGP / 64) * 512) = d2;
            EPI_BLK_END
        }
    }
};
struct EpiInProjZ { static constexpr bool ST16 = false;
    bf16_t* Zp;
    __device__ __forceinline__ void operator()(const f32x4 (&acc)[2][2][4][2], const Unit& u, int wr, int wc, int fr, int fq) const {
        if (u.ocol < 512) {
            EPI_BLK_BEGIN
                u32x4 d1, d2; epi_xch(lo_, pack8(acc[ai][0][m][0], acc[ai][0][m][1]), pack8(acc[ai][1][m][0], acc[ai][1][m][1]), d1, d2);
                bf16_t* p = Zp + (size_t)(u.orow + rb_ + r7_) * ZP + C_CB + u.ocol + cx_; *(u32x4*)p = d1; *(u32x4*)(p + (size_t)8 * ZP) = d2;
            EPI_BLK_END
        } else if (u.ocol < 1536) {
            EPI_BLK_BEGIN
                u32x2 a, b, d1, d2;
                a.x = cvtpk(acc[ai][0][m][0][0] * acc[ai][0][m][0][1], acc[ai][0][m][0][2] * acc[ai][0][m][0][3]); a.y = cvtpk(acc[ai][0][m][1][0] * acc[ai][0][m][1][1], acc[ai][0][m][1][2] * acc[ai][0][m][1][3]);
                b.x = cvtpk(acc[ai][1][m][0][0] * acc[ai][1][m][0][1], acc[ai][1][m][0][2] * acc[ai][1][m][0][3]); b.y = cvtpk(acc[ai][1][m][1][0] * acc[ai][1][m][1][1], acc[ai][1][m][1][2] * acc[ai][1][m][1][3]);
                epi_xch(lo_, a, b, d1, d2);
                bf16_t* p = Zp + (size_t)(u.orow + rb_ + r7_) * ZP + C_U + ((u.ocol - 512 + cx_) >> 1); *(u32x2*)p = d1; *(u32x2*)(p + (size_t)8 * ZP) = d2;
            EPI_BLK_END
        } else {
            EPI_LOOP_BEGIN
                const int zc = u.ocol - 1536 + cloc;
                if (zc < 24) *(u32x4*)(Zp + (size_t)(u.orow + rloc) * ZP + C_GN + zc) = pack8(v0, v1);
            EPI_LOOP_END
        }
    }
};
struct EpiMerge { static constexpr bool ST16 = true;
    bf16_t* T; const unsigned char* ZG; mutable u32x2 gkeep[16];
    __device__ __forceinline__ void mid(f32x4 (&acc)[2][2][4][2], const Unit& u, int wr, int wc, int fr, int fq) const {
        asm volatile("" : "+v"(fr), "+v"(fq));
        u32x2 gn_[16], gc_[16];
        { EPI_BLK_BEGIN
            const unsigned char* pn = ZG + zg_off(u.orow + rb_ + r7_, C_GMN + u.ocol + cx_); const unsigned char* pc = ZG + zg_off(u.orow + rb_ + r7_, C_GMC + u.ocol + cx_);
            gn_[(ai * 4 + m) * 2] = *(const u32x2*)pn; gn_[(ai * 4 + m) * 2 + 1] = *(const u32x2*)(pn + (size_t)(ZGP / 64) * 512);
            gc_[(ai * 4 + m) * 2] = *(const u32x2*)pc; gc_[(ai * 4 + m) * 2 + 1] = *(const u32x2*)(pc + (size_t)(ZGP / 64) * 512);
          EPI_BLK_END }
        asm volatile("" ::: "memory");
#pragma unroll
        for (int i = 0; i < 16; ++i) gkeep[i] = gc_[i];
        { EPI_BLK_BEGIN
            u32x2 gnv[2], gcv[2]; epi_xch(lo_, gn_[(ai * 4 + m) * 2], gn_[(ai * 4 + m) * 2 + 1], gnv[0], gnv[1]); epi_xch(lo_, gc_[(ai * 4 + m) * 2], gc_[(ai * 4 + m) * 2 + 1], gcv[0], gcv[1]);
#pragma unroll
            for (int bj = 0; bj < 2; ++bj) { f32x4 n0, n1, c0, c1; unpack8_fp8(gnv[bj], n0, n1); unpack8_fp8(gcv[bj], c0, c1);
#pragma unroll
                for (int e = 0; e < 4; ++e) { acc[ai][bj][m][0][e] *= (1.f + __expf(-c0[e])) * __builtin_amdgcn_rcpf(1.f + __expf(-n0[e])); acc[ai][bj][m][1][e] *= (1.f + __expf(-c1[e])) * __builtin_amdgcn_rcpf(1.f + __expf(-n1[e])); } }
          EPI_BLK_END }
    }
    __device__ __forceinline__ void operator()(const f32x4 (&acc)[2][2][4][2], const Unit& u, int wr, int wc, int fr, int fq) const {
        u32x2 gt[16];
#pragma unroll
        for (int i = 0; i < 16; ++i) gt[i] = gkeep[i];
        EPI_BLK_BEGIN
            u32x2 gv[2]; epi_xch(lo_, gt[(ai * 4 + m) * 2], gt[(ai * 4 + m) * 2 + 1], gv[0], gv[1]);
            u32x4 pk[2];
#pragma unroll
            for (int bj = 0; bj < 2; ++bj) { f32x4 g0, g1; unpack8_fp8(gv[bj], g0, g1); f32x4 o0, o1;
#pragma unroll
                for (int e = 0; e < 4; ++e) { o0[e] = sigm(g0[e]) * acc[ai][bj][m][0][e]; o1[e] = sigm(g1[e]) * acc[ai][bj][m][1][e]; }
                pk[bj] = pack8(o0, o1); }
            u32x4 d1, d2; epi_xch(lo_, pk[0], pk[1], d1, d2);
            bf16_t* p = T + (size_t)(u.orow + rb_ + r7_) * DM + u.ocol + cx_; *(u32x4*)p = d1; *(u32x4*)(p + (size_t)8 * DM) = d2;
        EPI_BLK_END
    }
};
struct EpiResBf16 { static constexpr bool ST16 = true;
    bf16_t* H; const bf16_t* X;
    __device__ __forceinline__ void operator()(const f32x4 (&acc)[2][2][4][2], const Unit& u, int wr, int wc, int fr, int fq) const {
        u32x4 xin[16];
        EPI_LOOP_BEGIN
            xin[(ai * 4 + m) * 2 + bj] = *(const u32x4*)(X + (size_t)(u.orow + rloc) * DM + u.ocol + cloc); (void)v0; (void)v1;
        EPI_LOOP_END
        asm volatile("" ::: "memory");
        EPI_BLK_BEGIN
            u32x4 pk[2];
#pragma unroll
            for (int bj = 0; bj < 2; ++bj) { f32x4 x0, x1; unpack8(xin[(ai * 4 + m) * 2 + bj], x0, x1); pk[bj] = pack8(x0 * ALPHA + acc[ai][bj][m][0], x1 * ALPHA + acc[ai][bj][m][1]); }
            u32x4 d1, d2; epi_xch(lo_, pk[0], pk[1], d1, d2);
            bf16_t* p = H + (size_t)(u.orow + rb_ + r7_) * DM + u.ocol + cx_; *(u32x4*)p = d1; *(u32x4*)(p + (size_t)8 * DM) = d2;
        EPI_BLK_END
    }
};
struct EpiPle { static constexpr bool ST16 = true;
    bf16_t* P; const float* bias; const bf16_t* X1; const unsigned char* T8; const float* stat; const float* lng; const float* lnb;
    __device__ __forceinline__ void operator()(const f32x4 (&acc)[2][2][4][2], const Unit& u, int wr, int wc, int fr, int fq) const {
        f32x4 bs[2][2], gs[2][2], bb[2][2];
#pragma unroll
        for (int bj = 0; bj < 2; ++bj) { const int col = u.ocol + wc * 64 + bj * 32 + 8 * fq; bs[bj][0] = *(const f32x4*)(bias + col); bs[bj][1] = *(const f32x4*)(bias + col + 4);
            gs[bj][0] = *(const f32x4*)(lng + col) * ALPHA; gs[bj][1] = *(const f32x4*)(lng + col + 4) * ALPHA; bb[bj][0] = *(const f32x4*)(lnb + col) * ALPHA; bb[bj][1] = *(const f32x4*)(lnb + col + 4) * ALPHA; }
        const bool lo_ = fr < 8; const int r7_ = fr & 7, cx_ = wc * 64 + 8 * fq + (lo_ ? 0 : 32);
#pragma unroll
        for (int ai = 0; ai < 2; ++ai) {
            u32x2 tin[8]; u32x4 xin[8]; f32x2 st[4];
#pragma unroll
            for (int m = 0; m < 4; ++m) { st[m] = *(const f32x2*)(stat + 2 * (size_t)(u.orow + ai * HALF + wr * 64 + m * 16 + fr));
#pragma unroll
                for (int bj = 0; bj < 2; ++bj) { const size_t off = (size_t)(u.orow + ai * HALF + wr * 64 + m * 16 + fr) * DM + u.ocol + wc * 64 + bj * 32 + 8 * fq;
                    tin[m * 2 + bj] = __builtin_nontemporal_load((const u32x2*)(T8 + off)); xin[m * 2 + bj] = __builtin_nontemporal_load((const u32x4*)(X1 + off)); } }
            asm volatile("" ::: "memory");
#pragma unroll
            for (int m = 0; m < 4; ++m) { u32x4 pk[2]; const float ra = st[m][1], rc = -st[m][0] * st[m][1];
#pragma unroll
                for (int bj = 0; bj < 2; ++bj) { const f32x4 v0 = acc[ai][bj][m][0], v1 = acc[ai][bj][m][1];
                    f32x4 t0, t1, x0, x1_; unpack8_fp8(tin[m * 2 + bj], t0, t1); unpack8(xin[m * 2 + bj], x0, x1_); f32x4 o0, o1;
#pragma unroll
                    for (int e = 0; e < 4; ++e) { o0[e] = ((x0[e] * ra + rc) * gs[bj][0][e] + bb[bj][0][e]) + sigm(v0[e] + bs[bj][0][e]) * t0[e]; o1[e] = ((x1_[e] * ra + rc) * gs[bj][1][e] + bb[bj][1][e]) + sigm(v1[e] + bs[bj][1][e]) * t1[e]; }
                    pk[bj] = pack8(o0, o1); }
                u32x4 d1, d2; epi_xch(lo_, pk[0], pk[1], d1, d2);
                bf16_t* p = P + (size_t)(u.orow + ai * HALF + wr * 64 + m * 16 + r7_) * DM + u.ocol + cx_; *(u32x4*)p = d1; *(u32x4*)(p + (size_t)8 * DM) = d2; }
            asm volatile("" ::: "memory");
        }
    }
};
struct EpiSwiGlu { static constexpr bool ST16 = false;
    unsigned char* HS8; const LAS float* WT;
    __device__ __forceinline__ void operator()(const f32x4 (&acc)[2][2][4][2], const Unit& u, int wr, int wc, int fr, int fq) const {
        const LAS float* wt_ = WT + u.idx * 256 + wr * 64 + fr;
        EPI_BLK_BEGIN
            unsigned hk[2]; const float w_ = wt_[ai * HALF + m * 16];
#pragma unroll
            for (int bj = 0; bj < 2; ++bj) { const f32x4 v0 = acc[ai][bj][m][0], v1 = acc[ai][bj][m][1];
                const float h0 = v0[0] * sigm(v0[0]) * v0[1], h1 = v0[2] * sigm(v0[2]) * v0[3], h2 = v1[0] * sigm(v1[0]) * v1[1], h3 = v1[2] * sigm(v1[2]) * v1[3];
                hk[bj] = (unsigned)pack4_fp8(h0 * w_, h1 * w_, h2 * w_, h3 * w_); }
            unsigned d1, d2; epi_xch(lo_, hk[0], hk[1], d1, d2);
            const int r1 = rb_ + r7_; unsigned char* p = HS8 + (size_t)(u.orow + r1) * EH + ((u.ocol + cx_) >> 1);
            if (r1 < u.nvalid) *(unsigned*)p = d1;
            if (r1 + 8 < u.nvalid) *(unsigned*)(p + (size_t)8 * EH) = d2;
        EPI_BLK_END
    }
};
struct EpiScaleRows { static constexpr bool ST16 = false;
    unsigned char* YS8;
    __device__ __forceinline__ void operator()(const f32x4 (&acc)[2][2][4][2], const Unit& u, int wr, int wc, int fr, int fq) const {
        EPI_BLK_BEGIN
            constexpr float w = 1.f; u32x2 a8, b8, d1, d2;
            a8.x = (unsigned)pack4_fp8(acc[ai][0][m][0][0] * w, acc[ai][0][m][0][1] * w, acc[ai][0][m][0][2] * w, acc[ai][0][m][0][3] * w); a8.y = (unsigned)pack4_fp8(acc[ai][0][m][1][0] * w, acc[ai][0][m][1][1] * w, acc[ai][0][m][1][2] * w, acc[ai][0][m][1][3] * w);
            b8.x = (unsigned)pack4_fp8(acc[ai][1][m][0][0] * w, acc[ai][1][m][0][1] * w, acc[ai][1][m][0][2] * w, acc[ai][1][m][0][3] * w); b8.y = (unsigned)pack4_fp8(acc[ai][1][m][1][0] * w, acc[ai][1][m][1][1] * w, acc[ai][1][m][1][2] * w, acc[ai][1][m][1][3] * w);
            epi_xch(lo_, a8, b8, d1, d2);
            const int r1 = rb_ + r7_; unsigned char* p = YS8 + (size_t)(u.orow + r1) * DM + u.ocol + cx_;
            if (r1 < u.nvalid) *(u32x2*)p = d1;
            if (r1 + 8 < u.nvalid) *(u32x2*)(p + (size_t)8 * DM) = d2;
        EPI_BLK_END
    }
};
}

#define XB_TMO      128
#define XB_XCNT(j)  (256  + 64 * (j))
#define XB_XSUB(j)  (1280 + 64 * (j))
#define XB_XGEN(j)  (2304 + 64 * (j))
#define XB_TOP      3328
#define XB_TOPGEN   3392
#define XCD_BAR_WORDS 3456
#define XB_SPIN_CAP (1u << 18)
__device__ __forceinline__ unsigned xb_ld(unsigned* p)              { return __hip_atomic_load(p, __ATOMIC_RELAXED, __HIP_MEMORY_SCOPE_AGENT); }
__device__ __forceinline__ unsigned xb_add(unsigned* p, unsigned v) { return __hip_atomic_fetch_add(p, v, __ATOMIC_RELAXED, __HIP_MEMORY_SCOPE_AGENT); }
__device__ __forceinline__ unsigned xb_xcc_id() { return (unsigned)__builtin_amdgcn_s_getreg((3 << 11) | 20) & 0xFu; }
#define XB_SPIN(cond, bar) do { unsigned _sp = 0; while (cond) { __builtin_amdgcn_s_sleep(1); \
    if ((++_sp & 255u) == 0u) { if (xb_ld(&(bar)[XB_TMO])) break; if (_sp > XB_SPIN_CAP) { atomicAdd(&(bar)[XB_TMO], 1u); break; } } } } while (0)
struct XcdBarrier { unsigned* bar; unsigned x; volatile LAS unsigned* st; };
__device__ __forceinline__ XcdBarrier xcd_barrier_post(unsigned* bar, volatile LAS unsigned* st) {
    XcdBarrier b; b.bar = bar; b.x = xb_xcc_id(); b.st = st;
    if (threadIdx.x == 0) (void)xb_add(&bar[XB_XCNT(b.x)], 1u);
    return b;
}
__device__ __forceinline__ void xcd_barrier_complete(unsigned* bar, unsigned x, unsigned& nloc, unsigned& nx) {
    const unsigned G = gridDim.x * gridDim.y * gridDim.z;
    unsigned sum, cnt, mine, sp = 0u;
    for (;;) {
        sum = 0u; cnt = 0u; mine = 0u;
#pragma unroll
        for (unsigned j = 0; j < 16; ++j) { const unsigned c = xb_ld(&bar[XB_XCNT(j)]); sum += c; cnt += (c > 0u) ? 1u : 0u; mine = (j == x) ? c : mine; }
        if (sum == G) break;
        __builtin_amdgcn_s_sleep(1);
        if ((++sp & 255u) == 0u) { if (xb_ld(&bar[XB_TMO])) break; if (sp > XB_SPIN_CAP) { atomicAdd(&bar[XB_TMO], 1u); break; } }
    }
    nloc = mine > 0u ? mine : 1u; nx = cnt > 0u ? cnt : 1u;
}
__device__ __forceinline__ void xcd_barrier(const XcdBarrier& b) {
    asm volatile("s_waitcnt vmcnt(0)" ::: "memory");
    __syncthreads();
    if (threadIdx.x == 0) {
        unsigned* bar = b.bar;
        __builtin_amdgcn_s_waitcnt(0);
        unsigned nloc = b.st[0], nx = b.st[1];
        if (nloc == 0u) { xcd_barrier_complete(bar, b.x, nloc, nx); b.st[0] = nloc; b.st[1] = nx; }
        const unsigned old = xb_add(&bar[XB_XSUB(b.x)], 1u);
        const unsigned gen = old / nloc;
        if (old + 1u == (gen + 1u) * nloc) {
            __builtin_amdgcn_fence(__ATOMIC_RELEASE, "agent");
            asm volatile("s_waitcnt vmcnt(0)" ::: "memory");
            const unsigned og = xb_add(&bar[XB_TOP], 1u);
            const unsigned tg = og / nx;
            if (og + 1u == (tg + 1u) * nx) xb_add(&bar[XB_TOPGEN], 1u);
            else XB_SPIN(xb_ld(&bar[XB_TOPGEN]) == tg, bar);
            __builtin_amdgcn_fence(__ATOMIC_ACQUIRE, "agent");
            xb_add(&bar[XB_XGEN(b.x)], 1u);
            asm volatile("s_waitcnt vmcnt(0)" ::: "memory");
        } else {
            XB_SPIN(xb_ld(&bar[XB_XGEN(b.x)]) == gen, bar);
            __builtin_amdgcn_fence(__ATOMIC_ACQUIRE, "agent");
            asm volatile("s_waitcnt vmcnt(0)" ::: "memory");
        }
    }
    __syncthreads();
}


namespace att {
typedef float f32x16 __attribute__((ext_vector_type(16)));
typedef short s16x4 __attribute__((ext_vector_type(4)));
constexpr int L_K = 0, L_V = 32768, L_WSF = 65536, L_IMPG = 67584, L_OST = L_IMPG, L_IMPL = L_IMPG + 33792, L_SC = L_IMPL + 33792, L_SELM = L_SC + 64 * 36 * 4, L_UNI = L_SELM + 256, L_END = L_UNI + 16;
static_assert(L_END <= LDS_BYTES - RING_OFF, "attention LDS map");
constexpr float NEG = -2e30f, MINIT = -1e30f;
#define MFMA32(a, b, c) __builtin_amdgcn_mfma_f32_32x32x16_bf16((a), (b), (c), 0, 0, 0)
__device__ __forceinline__ int crow(int r, int hi) { return (r & 3) + 8 * (r >> 2) + 4 * hi; }
__device__ __forceinline__ void glds16s(const void* sbase_, unsigned voff, unsigned lds_dst) { unsigned keep;
    const unsigned long long sb_ = (unsigned long long)sbase_;
    const unsigned long long sbase = ((unsigned long long)(unsigned)__builtin_amdgcn_readfirstlane((int)(sb_ >> 32)) << 32) | (unsigned)__builtin_amdgcn_readfirstlane((int)sb_);
    asm volatile("s_mov_b32 %0, m0\n\ts_mov_b32 m0, %3\n\ts_nop 0\n\tglobal_load_lds_dwordx4 %1, %2\n\ts_mov_b32 m0, %0" : "=&s"(keep) : "v"(voff), "s"(sbase), "s"(lds_dst) : "memory"); }
__device__ __forceinline__ int kswz(int r) { return (r & 7) ^ ((r >> 3) & 1); }
__device__ __forceinline__ unsigned kdma_off(int wid, int lane) { const int r = 8 * wid + (lane >> 3); return (unsigned)(r * 128 + (((lane & 7) ^ kswz(r)) << 4)); }
__device__ __forceinline__ unsigned vdma_off(int wid, int lane) { return (unsigned)((8 * wid + (lane >> 3)) * 128 + ((((lane & 7) >> 1) ^ ((lane >> 3) & 2)) << 5) + ((lane & 1) << 4)); }
__device__ __forceinline__ int kfrag_off(int r32, int hi) { return r32 * 128 + ((hi ^ kswz(r32)) << 4); }
__device__ __forceinline__ void dma_kv(const bf16_t* Kb, const bf16_t* Vb, int tile, unsigned kdst, unsigned vdst, int wid, int lane) {
    glds16s(Kb + (size_t)tile * 4096, kdma_off(wid, lane), kdst + (unsigned)wid * 1024u);
    glds16s(Vb + (size_t)tile * 4096, vdma_off(wid, lane), vdst + (unsigned)wid * 1024u);
}
__device__ __forceinline__ void branch_prologue(const bf16_t* Kb, const bf16_t* Vb, int qt, int t1, unsigned lds0, int wid, int lane) {
    glds16s(Kb + (size_t)qt * 4096, kdma_off(wid, lane), lds0 + L_K + (unsigned)wid * 1024u);
    if (t1 >= 0) glds16s(Kb + (size_t)t1 * 4096, kdma_off(wid, lane), lds0 + L_K + 8192u + (unsigned)wid * 1024u);
    glds16s(Vb + (size_t)qt * 4096, vdma_off(wid, lane), lds0 + L_V + (unsigned)wid * 1024u);
}
__device__ __forceinline__ void qkt(f32x16& p0, f32x16& p1, const LAS unsigned char* Kslot, const bf16x8* qr, int r32, int hi) {
    const unsigned kb = (unsigned)(size_t)Kslot + (unsigned)kfrag_off(r32, hi);
    f32x16 z; for (int i = 0; i < 16; ++i) z[i] = 0.f;
    p0 = z; p1 = z;
#pragma unroll
    for (int d0 = 0; d0 < 4; ++d0) { const LAS unsigned char* kd = (const LAS unsigned char*)(size_t)(kb ^ (unsigned)(d0 << 5)); const bf16x8 b0 = *(const LAS bf16x8*)(kd), b1 = *(const LAS bf16x8*)(kd + 4096);
        p0 = MFMA32(b0, qr[d0], p0); p1 = MFMA32(b1, qr[d0], p1); }
}
__device__ __forceinline__ void pv(f32x16* o, unsigned vb, bf16x8 pa0, bf16x8 pa1, bf16x8 pa2, bf16x8 pa3) {
#pragma unroll
    for (int d0 = 0; d0 < 2; ++d0) { s16x4 lo[4], hi[4];
#pragma unroll
        for (int ks = 0; ks < 4; ++ks) {
            asm volatile("ds_read_b64_tr_b16 %0,%1 offset:%c2" : "=&v"(lo[ks]) : "v"(vb ^ (unsigned)(d0 << 6)), "i"(ks * 2048) : "memory");
            asm volatile("ds_read_b64_tr_b16 %0,%1 offset:%c2" : "=&v"(hi[ks]) : "v"(vb ^ (unsigned)(d0 << 6)), "i"(ks * 2048 + 1024) : "memory"); }
        asm volatile("s_waitcnt lgkmcnt(0)" ::: "memory"); __builtin_amdgcn_sched_barrier(0);
#define PK(k) (bf16x8){lo[k][0], lo[k][1], lo[k][2], lo[k][3], hi[k][0], hi[k][1], hi[k][2], hi[k][3]}
        o[d0] = MFMA32(pa0, PK(0), o[d0]); o[d0] = MFMA32(pa1, PK(1), o[d0]); o[d0] = MFMA32(pa2, PK(2), o[d0]); o[d0] = MFMA32(pa3, PK(3), o[d0]);
#undef PK
    }
}
__device__ __forceinline__ float half_swap_max(float m) { auto rr = __builtin_amdgcn_permlane32_swap(__float_as_uint(m), __float_as_uint(m), false, false); return __builtin_fmaxf(__uint_as_float(rr[0]), __uint_as_float(rr[1])); }
__device__ __forceinline__ float half_swap_sum(float m) { auto rr = __builtin_amdgcn_permlane32_swap(__float_as_uint(m), __float_as_uint(m), false, false); return __uint_as_float(rr[0]) + __uint_as_float(rr[1]); }
__device__ __forceinline__ float rowmax32(const f32x16& p0, const f32x16& p1) { float a = __builtin_fmaxf(p0[0], p1[0]);
#pragma unroll
    for (int r = 1; r < 16; ++r) a = __builtin_fmaxf(a, __builtin_fmaxf(p0[r], p1[r]));
    return half_swap_max(a); }
__device__ __forceinline__ bf16x8 packp(const f32x16& p, int b) { u32x4 w; w.x = cvtpk(p[b], p[b + 1]); w.y = cvtpk(p[b + 2], p[b + 3]); w.z = cvtpk(p[b + 4], p[b + 5]); w.w = cvtpk(p[b + 6], p[b + 7]); return __builtin_bit_cast(bf16x8, w); }
__device__ __forceinline__ float max3f(float a, float b, float c) { return __builtin_fmaxf(__builtin_fmaxf(a, b), c); }
constexpr float THR = 8.f;
__device__ __forceinline__ void mask_tile(f32x16& p0, f32x16& p1, int mode, bool, int ql, int hi) {
    const int x = ql - 4 * hi;
    if (mode == 1) {
#pragma unroll
        for (int r = 0; r < 16; ++r) { const int cr = (r & 3) + 8 * (r >> 2); p0[r] = (x < cr) ? NEG : p0[r]; p1[r] = (x < cr + 32) ? NEG : p1[r]; }
    } else {
#pragma unroll
        for (int r = 0; r < 16; ++r) { const int cr = (r & 3) + 8 * (r >> 2); p0[r] = (x >= cr) ? NEG : p0[r]; p1[r] = (x >= cr + 32) ? NEG : p1[r]; }
    }
}
__device__ __forceinline__ float max32(const f32x16& p0, const f32x16& p1) {
    float a = max3f(p0[0], p0[1], p1[0]), b = max3f(p0[2], p0[3], p1[1]); a = max3f(a, p1[2], p1[3]);
#pragma unroll
    for (int r = 4; r < 16; r += 4) { a = max3f(a, p0[r], p0[r + 1]); b = max3f(b, p0[r + 2], p0[r + 3]); a = max3f(a, p1[r], p1[r + 1]); b = max3f(b, p1[r + 2], p1[r + 3]); }
    return __builtin_fmaxf(a, b);
}
typedef __attribute__((address_space(3))) const unsigned char* lds_cptr;
typedef short v4i16_t __attribute__((ext_vector_type(4)));
__device__ __forceinline__ s16x4 vtr(lds_cptr p) { return __builtin_bit_cast(s16x4, __builtin_amdgcn_ds_read_tr16_b64_v4i16((__attribute__((address_space(3))) v4i16_t*)p)); }
__device__ __forceinline__ void kload8(bf16x8* kf, lds_cptr kp) {
    const unsigned k0 = (unsigned)(size_t)kp;
#pragma unroll
    for (int d0 = 0; d0 < 4; ++d0) { lds_cptr kd = (lds_cptr)(size_t)(k0 ^ (unsigned)(d0 << 5)); kf[2 * d0] = *(const LAS bf16x8*)(kd); kf[2 * d0 + 1] = *(const LAS bf16x8*)(kd + 4096); } }

template <bool SEL, bool PRE = false, bool NEXT = false>
__device__ __forceinline__ void run_branch_pipe(f32x16* o, float& l_out, unsigned tiles, unsigned selm, int qt, int jw, const bf16_t* Kb, const bf16_t* Vb, LAS unsigned char* ring, unsigned lds0,
                                                const bf16x8* qr, int r32, int hi, int ql, int wid, int lane, unsigned vtr_off, LAS float* wsf,
                                                int& rot) {
    constexpr size_t NXT = (size_t)(HS_KW - HS_KS) * BATCH * SEQ * 64;
#define P_SBAR() __builtin_amdgcn_sched_barrier(0)
#define P_PIN(x) asm volatile("" : "+v"(x))
#define P_WB(n) asm volatile("s_waitcnt vmcnt(" #n ") lgkmcnt(0)\n\ts_barrier" ::: "memory")
#define P_WBN(n_) do { const int nn_ = (n_); if (nn_ <= 0) P_WB(0); else if (nn_ == 1) P_WB(1); else P_WB(2); } while (0)
#define P_PKW(P, B) (SEL ? (cvtpk(P[B], P[B + 1]) & onm_prev) : cvtpk(P[B], P[B + 1]))
#define P_PAF(k) __builtin_bit_cast(bf16x8, pw##k)
#define P_VFR(i) (bf16x8){vlo[i][0], vlo[i][1], vlo[i][2], vlo[i][3], vhi[i][0], vhi[i][1], vhi[i][2], vhi[i][3]}
#define P_GAPA(MF, A0, A1, A2, A3, W0, W1, PW) do { MF; sacc += A0; sacc += A1; sacc += A2; sacc += A3; P_PIN(sacc); W0; W1; P_PIN(PW); P_SBAR(); } while (0)
#define P_EX(v) __builtin_amdgcn_exp2f(v)
#define P_GAPB(MF, X, B) do { MF; X[B] = P_EX(X[B]); X[B + 1] = P_EX(X[B + 1]); X[B + 2] = P_EX(X[B + 2]); X[B + 3] = P_EX(X[B + 3]); P_PIN(X); P_SBAR(); } while (0)
#define P_VRD(i) do { vlo[i] = vtr((((i) >> 2) ? vp1_ : vp_) + ((i) & 3) * 2048); vhi[i] = vtr((((i) >> 2) ? vp1_ : vp_) + ((i) & 3) * 2048 + 1024); } while (0)
#define P_DMAK(t_, slot_) glds16s(Kb + (size_t)(t_) * 4096, kdma_off(wid, lane), lds0 + L_K + (unsigned)(slot_) * 8192u + (unsigned)wid * 1024u)
#define P_DMAV(t_, slot_) glds16s(Vb + (size_t)(t_) * 4096, vdma_off(wid, lane), lds0 + L_V + (unsigned)(slot_) * 8192u + (unsigned)wid * 1024u)
#define P_ISSUE() do { n_last = 0; if (tq2 >= 0) { P_DMAK(tq2, s2); ++n_last; } if (tq1 >= 0) { P_DMAV(tq1, s1); ++n_last; } } while (0)
#define P_SHIFT() do { tq0 = tq1; tq1 = tq2; tq2 = -1; if (rem) { tq2 = __builtin_ctz(rem); rem &= rem - 1u; } const int s_ = s0; s0 = s1; s1 = s2; s2 = s_; } while (0)
#define P_RESC() do { if (resc) { LDS_WAIT(); _Pragma("unroll") for (int r = 0; r < 16; ++r) { const float f_ = wsf[crow(r, hi)]; o[0][r] *= f_; o[1][r] *= f_; } } } while (0)
#define P_STEP(C0, C1, P0, P1) do { P_SBAR(); \
    const unsigned onm_cur = SEL ? (0u - ((selm >> tq0) & 1u)) : 0xffffffffu; \
    kload8(kf, (lds_cptr)(ring + L_K + s0 * 8192) + kfrag_off(r32, hi)); \
    const lds_cptr vp_ = (lds_cptr)(ring + L_V + s2 * 8192) + vtr_off; const lds_cptr vp1_ = (lds_cptr)(size_t)((unsigned)(size_t)vp_ ^ 64u); \
    float sacc = (P0[0] + P0[1]); \
    P_GAPA(C0 = MFMA32(kf[0], qr[0], negm), P0[2], P0[3], P0[4], P0[5],     pw0[0] = P_PKW(P0, 0), pw0[1] = P_PKW(P0, 2), pw0); \
    P_GAPA(C1 = MFMA32(kf[1], qr[0], negm), P0[6], P0[7], P0[8], P0[9],     pw0[2] = P_PKW(P0, 4), pw0[3] = P_PKW(P0, 6), pw0); \
    P_GAPA(C0 = MFMA32(kf[2], qr[1], C0),   P0[10], P0[11], P0[12], P0[13], pw1[0] = P_PKW(P0, 8), pw1[1] = P_PKW(P0, 10), pw1); \
    P_GAPA(C1 = MFMA32(kf[3], qr[1], C1),   P0[14], P0[15], P1[0], P1[1],   pw1[2] = P_PKW(P0, 12), pw1[3] = P_PKW(P0, 14), pw1); \
    P_GAPA(C0 = MFMA32(kf[4], qr[2], C0),   P1[2], P1[3], P1[4], P1[5],     pw2[0] = P_PKW(P1, 0), pw2[1] = P_PKW(P1, 2), pw2); \
    P_GAPA(C1 = MFMA32(kf[5], qr[2], C1),   P1[6], P1[7], P1[8], P1[9],     pw2[2] = P_PKW(P1, 4), pw2[3] = P_PKW(P1, 6), pw2); \
    P_GAPA(C0 = MFMA32(kf[6], qr[3], C0),   P1[10], P1[11], P1[12], P1[13], pw3[0] = P_PKW(P1, 8), pw3[1] = P_PKW(P1, 10), pw3); \
    P_GAPA(C1 = MFMA32(kf[7], qr[3], C1),   P1[14], P1[15], 0.f, 0.f,       pw3[2] = P_PKW(P1, 12), pw3[3] = P_PKW(P1, 14), pw3); \
    l_reg += SEL ? __uint_as_float(__float_as_uint(sacc) & onm_prev) : sacc; onm_prev = onm_cur; \
    P_VRD(0); P_VRD(4); \
    if (!SEL) { if (tq0 == jw) { asm volatile("" ::: "memory"); mask_tile(C0, C1, 2, true, ql, hi); } }     \
    { float rm = half_swap_max(max32(C0, C1)); resc = false; \
      if (__builtin_expect(__any(rm > THR), 0)) { const float dl = __builtin_fmaxf(rm, 0.f); mref += dl; \
          _Pragma("unroll") for (int r = 0; r < 16; ++r) { C0[r] -= dl; C1[r] -= dl; } \
          _Pragma("unroll") for (int r = 0; r < 16; ++r) negm[r] = -mref; asm volatile("" : "+v"(negm)); \
          const float f = __builtin_amdgcn_exp2f(-dl); l_reg *= f; if (hi == 0) wsf[r32] = f; resc = true; } } \
    P_SBAR(); \
    P_VRD(1); P_GAPB(o[0] = MFMA32(P_PAF(0), P_VFR(0), o[0]), C0, 0); \
    P_VRD(5); P_GAPB(o[1] = MFMA32(P_PAF(0), P_VFR(4), o[1]), C0, 4); \
    P_VRD(2); P_GAPB(o[0] = MFMA32(P_PAF(1), P_VFR(1), o[0]), C0, 8); \
    P_VRD(6); P_GAPB(o[1] = MFMA32(P_PAF(1), P_VFR(5), o[1]), C0, 12); \
    P_VRD(3); P_GAPB(o[0] = MFMA32(P_PAF(2), P_VFR(2), o[0]), C1, 0); \
    P_VRD(7); P_GAPB(o[1] = MFMA32(P_PAF(2), P_VFR(6), o[1]), C1, 4); \
    P_GAPB(o[0] = MFMA32(P_PAF(3), P_VFR(3), o[0]), C1, 8); \
    P_GAPB(o[1] = MFMA32(P_PAF(3), P_VFR(7), o[1]), C1, 12); \
    } while (0)
#define P_DRAIN(PB0, PB1) do { P_WB(0); \
      if constexpr (NEXT) { glds16s(Kb + NXT + (size_t)qt * 4096, kdma_off(wid, lane), lds0 + L_K + (unsigned)s0 * 8192u + (unsigned)wid * 1024u); \
          if (qt > 0) glds16s(Kb + NXT + (size_t)(qt >= 8 ? qt - 8 : 0) * 4096, kdma_off(wid, lane), lds0 + L_K + (unsigned)s1 * 8192u + (unsigned)wid * 1024u); \
          glds16s(Vb + NXT + (size_t)qt * 4096, vdma_off(wid, lane), lds0 + L_V + (unsigned)s0 * 8192u + (unsigned)wid * 1024u); rot = s0; } \
      float sacc = 0.f; \
      _Pragma("unroll") for (int r = 0; r < 16; ++r) sacc += PB0[r] + PB1[r]; \
      l_reg += SEL ? __uint_as_float(__float_as_uint(sacc) & onm_prev) : sacc; \
      u32x4 d0_ = __builtin_bit_cast(u32x4, packp(PB0, 0)), d1_ = __builtin_bit_cast(u32x4, packp(PB0, 8)), d2_ = __builtin_bit_cast(u32x4, packp(PB1, 0)), d3_ = __builtin_bit_cast(u32x4, packp(PB1, 8)); \
      if (SEL) { d0_ &= onm_prev; d1_ &= onm_prev; d2_ &= onm_prev; d3_ &= onm_prev; } \
      pv(o, lds0 + L_V + (unsigned)s2 * 8192u + vtr_off, __builtin_bit_cast(bf16x8, d0_), __builtin_bit_cast(bf16x8, d1_), __builtin_bit_cast(bf16x8, d2_), __builtin_bit_cast(bf16x8, d3_)); } while (0)
#define P_BODY(C0, C1, P0, P1) do { P_WBN(n_last); P_ISSUE(); P_STEP(C0, C1, P0, P1); P_RESC(); P_SHIFT(); } while (0)
    unsigned rem = tiles & ~(1u << qt);
    int tq0 = qt, tq1 = -1, tq2 = -1, s0 = PRE ? rot : 0, s1 = s0 == 2 ? 0 : s0 + 1, s2 = s1 == 2 ? 0 : s1 + 1, n_last;
    if (rem) { tq1 = __builtin_ctz(rem); rem &= rem - 1u; }
    if (rem) { tq2 = __builtin_ctz(rem); rem &= rem - 1u; }
    if constexpr (!PRE) {
    P_DMAK(tq0, 0);
    if (tq1 >= 0) P_DMAK(tq1, 1);
    P_DMAV(tq0, 0);
    }
    float mref = 0.f, l_reg = 0.f; bool resc = false; unsigned onm_prev = 0xffffffffu;
    f32x16 negm; for (int i = 0; i < 16; ++i) { negm[i] = 0.f; o[0][i] = 0.f; o[1][i] = 0.f; }
    bf16x8 kf[8]; s16x4 vlo[8], vhi[8]; u32x4 pw0, pw1, pw2, pw3;
    f32x16 pA0, pA1, pB0, pB1;
    P_WBN((tq1 >= 0 ? 1 : 0) + 1);
    P_ISSUE();
    { kload8(kf, (lds_cptr)(ring + L_K + s0 * 8192) + kfrag_off(r32, hi));
      pA0 = negm; pA1 = negm;
#pragma unroll
      for (int d0 = 0; d0 < 4; ++d0) { pA0 = MFMA32(kf[2 * d0], qr[d0], pA0); pA1 = MFMA32(kf[2 * d0 + 1], qr[d0], pA1); }
      mask_tile(pA0, pA1, 1, true, ql, hi);
      const float rm = half_swap_max(max32(pA0, pA1)); mref = rm;
#pragma unroll
      for (int r = 0; r < 16; ++r) { pA0[r] = P_EX(pA0[r] - rm); pA1[r] = P_EX(pA1[r] - rm); negm[r] = -rm; }
      asm volatile("" : "+v"(negm)); }
    P_SHIFT();
    if (tq0 < 0) { P_DRAIN(pA0, pA1); }
    else for (;;) {
        P_BODY(pB0, pB1, pA0, pA1); if (tq0 < 0) { P_DRAIN(pB0, pB1); break; }
        P_BODY(pA0, pA1, pB0, pB1); if (tq0 < 0) { P_DRAIN(pA0, pA1); break; }
    }
    l_out = l_reg;
    asm volatile("s_waitcnt lgkmcnt(0)\n\ts_barrier" ::: "memory");
#undef P_SBAR
#undef P_PIN
#undef P_WB
#undef P_WBN
#undef P_PKW
#undef P_PAF
#undef P_VFR
#undef P_GAPA
#undef P_EX
#undef P_GAPB
#undef P_VRD
#undef P_DMAK
#undef P_DMAV
#undef P_ISSUE
#undef P_SHIFT
#undef P_RESC
#undef P_STEP
#undef P_DRAIN
#undef P_BODY
}
__device__ __forceinline__ void fold_branch_lds(LAS float* ocb, const f32x16* o_, float l_, float gate, bool add, int r32, int hi, LAS float* wsf) {
    const float lt = half_swap_sum(l_); const float fac = lt > 0.f ? gate / lt : 0.f;
    if (hi == 0) wsf[r32] = fac;
    LDS_WAIT();
#pragma unroll
    for (int r = 0; r < 16; ++r) { const float f = wsf[crow(r, hi)]; LAS float* p = ocb + crow(r, hi) * 64 + r32;
        if (add) { p[0] += o_[0][r] * f; p[32] += o_[1][r] * f; } else { p[0] = o_[0][r] * f; p[32] = o_[1][r] * f; } }
}
__device__ __forceinline__ float gelu_tanh(float x) { const float u = 0.7978845608028654f * (x + 0.044715f * x * x * x); const float th = 1.f - 2.f / (__expf(2.f * u) + 1.f); return 0.5f * x * (1.f + th); }

__device__ __forceinline__ void compress_pair(int item, const bf16_t* HM, const bf16_t* W1, const bf16_t* W2, const float* b1f, const float* b2, bf16_t* KCV, LAS unsigned char* ring, int wid, int lane) {
    const int kv = item & 1, nt4 = (item >> 1) & 3, bg = item >> 3, b = bg >> 1, g = bg & 1;
    const int r32 = lane & 31, hi = lane >> 5, cb = wid & 3, kh = wid >> 2;
    const int n = 32 * nt4 + r32;
    const bf16_t* abase0 = HM + (size_t)(((kv ? HS_VC : HS_KC) + g) * BATCH + b) * SEQ * 64 + 8 * hi;
    const bf16_t* abase1 = abase0 + (size_t)16 * SEQ * 64;
    const bf16_t* wb = W1 + ((size_t)kv * 128 + 32 * cb + r32) * 2048 + 1024 * kh + 8 * hi;
    f32x16 acc0, acc1; for (int i = 0; i < 16; ++i) { acc0[i] = 0.f; acc1[i] = 0.f; }
#pragma unroll 16
    for (int ks = 0; ks < 64; ++ks) { const int l = 16 * kh + (ks >> 2); int tok = 16 * n + l; tok = tok < SEQ ? tok : SEQ - 1;
        const bf16x8 a0 = *(const bf16x8*)(abase0 + (size_t)tok * 64 + 16 * (ks & 3)), a1 = *(const bf16x8*)(abase1 + (size_t)tok * 64 + 16 * (ks & 3)); const bf16x8 bw = *(const bf16x8*)(wb + 16 * ks);
        acc0 = MFMA32(a0, bw, acc0); acc1 = MFMA32(a1, bw, acc1); }
    LAS float* RED = (LAS float*)ring;
    LAS bf16_t* HID = (LAS bf16_t*)(ring + 2 * 4 * 32 * 33 * 4);
    if (kh == 1) {
#pragma unroll
        for (int i = 0; i < 16; ++i) { RED[(cb * 32 + crow(i, hi)) * 33 + r32] = acc0[i]; RED[4 * 32 * 33 + (cb * 32 + crow(i, hi)) * 33 + r32] = acc1[i]; } }
    __syncthreads();
    if (kh == 0) {
#pragma unroll
        for (int i = 0; i < 16; ++i) { const int row = crow(i, hi), col = 32 * cb + r32; const float bias = b1f[kv * 128 + col];
            const float v0 = acc0[i] + RED[(cb * 32 + row) * 33 + r32] + bias, v1 = acc1[i] + RED[4 * 32 * 33 + (cb * 32 + row) * 33 + r32] + bias;
            HID[row * 136 + col] = (bf16_t)(cvtpk(gelu_tanh(v0), 0.f) & 0xffffu); HID[32 * 136 + row * 136 + col] = (bf16_t)(cvtpk(gelu_tanh(v1), 0.f) & 0xffffu); } }
    __syncthreads();
    if (wid < 4) {
        const int it = wid >> 1, ch = wid & 1;
        f32x16 o; for (int i = 0; i < 16; ++i) o[i] = 0.f;
        const bf16_t* w2b = W2 + ((size_t)kv * 64 + 32 * ch + r32) * 128 + 8 * hi;
#pragma unroll
        for (int ks = 0; ks < 8; ++ks) { const bf16x8 a = *(const LAS bf16x8*)(HID + it * 32 * 136 + r32 * 136 + 16 * ks + 8 * hi); const bf16x8 bw = *(const bf16x8*)(w2b + 16 * ks); o = MFMA32(a, bw, o); }
        bf16_t* dst = KCV + (size_t)kv * (64 * 128 * 64) + (size_t)(bg + 32 * it) * 128 * 64;
#pragma unroll
        for (int i = 0; i < 16; ++i) { const int row = crow(i, hi), col = 32 * ch + r32; dst[(size_t)(32 * nt4 + row) * 64 + col] = (bf16_t)(cvtpk(o[i] + b2[kv * 64 + col], 0.f) & 0xffffu); }
    }
    __syncthreads();
}
}

constexpr int CW_TMO = 0, CW_CODE = 1, CW_BAR = 4096;
struct Args { const float* in[26]; float* out; unsigned char* ws; int ph_lo, ph_hi; };
struct Frame {
    LAS unsigned char* lds; volatile LAS unsigned* MISC; int wave, vcu, G;
};
__device__ __forceinline__ float wave_sum(float v) {
    v += __builtin_bit_cast(float, __builtin_amdgcn_update_dpp(0, __builtin_bit_cast(int, v), 0xB1, 0xf, 0xf, true));
    v += __builtin_bit_cast(float, __builtin_amdgcn_update_dpp(0, __builtin_bit_cast(int, v), 0x4E, 0xf, 0xf, true));
    v += __builtin_bit_cast(float, __builtin_amdgcn_update_dpp(0, __builtin_bit_cast(int, v), 0x141, 0xf, 0xf, true));
    v += __builtin_bit_cast(float, __builtin_amdgcn_update_dpp(0, __builtin_bit_cast(int, v), 0x140, 0xf, 0xf, true));
    { auto rr = __builtin_amdgcn_permlane16_swap(__float_as_uint(v), __float_as_uint(v), false, false); v = __uint_as_float(rr[0]) + __uint_as_float(rr[1]); }
    { auto rr = __builtin_amdgcn_permlane32_swap(__float_as_uint(v), __float_as_uint(v), false, false); v = __uint_as_float(rr[0]) + __uint_as_float(rr[1]); }
    return v;
}

__device__ __forceinline__ void p0_tr_item(const float* W, int K, int N, int nblk, bf16_t* WT, int rmul, int roff, int nscale, float sc, LAS float* scr, int item, int lane, int ldt = 0, int koff = 0, int f8 = 0, int ldw = 0) {
    if (ldt == 0) ldt = K;
    if (ldw == 0) ldw = N;
    const int kb = item / nblk, nb = item % nblk, k0 = 64 * kb, n0 = 32 * nb;
    const int nn = n0 + (lane & 31); const bool ok = nn < N;
    float tv[32];
#pragma unroll
    for (int i = 0; i < 32; ++i) { const int kk = 2 * i + (lane >> 5); tv[i] = ok ? W[(size_t)(k0 + kk) * ldw + nn] : 0.f; }
#pragma unroll
    for (int i = 0; i < 32; ++i) { const int kk = 2 * i + (lane >> 5); scr[kk * 33 + (lane & 31)] = tv[i]; }
    LDS_WAIT(); asm volatile("" ::: "memory");
    const int c = lane & 7;
#pragma unroll
    for (int j = 0; j < 4; ++j) { const int n = (lane >> 3) + 8 * j; const LAS float* s = scr + (8 * c) * 33 + n; const float f = (n0 + n < nscale) ? sc : 1.f;
        u32x4 o; o.x = cvtpk(s[0 * 33] * f, s[1 * 33] * f); o.y = cvtpk(s[2 * 33] * f, s[3 * 33] * f); o.z = cvtpk(s[4 * 33] * f, s[5 * 33] * f); o.w = cvtpk(s[6 * 33] * f, s[7 * 33] * f);
        if (f8) { const float f8s = f * 32.f; u32x2 o8; o8.x = (unsigned)pack4_fp8(s[0 * 33] * f8s, s[1 * 33] * f8s, s[2 * 33] * f8s, s[3 * 33] * f8s); o8.y = (unsigned)pack4_fp8(s[4 * 33] * f8s, s[5 * 33] * f8s, s[6 * 33] * f8s, s[7 * 33] * f8s);
                  *(u32x2*)((unsigned char*)WT + (size_t)(roff + (n0 + n) * rmul) * ldt + k0 + 8 * c) = o8; }
        else *(u32x4*)(WT + (size_t)(roff + (n0 + n) * rmul) * ldt + koff + k0 + 8 * c) = o; }
    LDS_WAIT(); asm volatile("" ::: "memory");
}

__global__ void __launch_bounds__(NWAVES * 64, 2) nsa_fwd(Args args) {
    extern __shared__ __attribute__((aligned(16))) unsigned char lds_raw[];
    Frame F;
    F.lds = (LAS unsigned char*)lds_raw;
    F.MISC = (volatile LAS unsigned*)(F.lds + LDS_MISC);
    F.wave = __builtin_amdgcn_readfirstlane((int)threadIdx.x >> 6);
    F.G = gridDim.x; { const int bx = blockIdx.x; F.vcu = (F.G % 8 == 0) ? (bx % 8) * (F.G / 8) + bx / 8 : bx; }
    unsigned char* ws = args.ws;
    gu32* ctl = (gu32*)(ws + WS_CTL);
    for (int u = threadIdx.x; u < 256; u += NWAVES * 64) ((LAS unsigned*)(F.lds + LDS_MISC))[u] = 0u;
    __syncthreads();
    XcdBarrier bar = xcd_barrier_post((unsigned*)(ctl + CW_BAR), F.MISC + 8);
    const int lo = args.ph_lo, hi = args.ph_hi;
#define IN(k) (lo <= (k) && (k) < hi)
#define SEAM(k) do { if (IN(k) && IN((k) + 1)) xcd_barrier(bar); } while (0)
    LAS unsigned char* ring = F.lds + RING_OFF;
    const int gw = F.vcu * NWAVES + F.wave, NGW = F.G * NWAVES;

    const float* x = args.in[0]; const float* p_in = args.in[1]; const float* w_in = args.in[2];
    const float* conv_w = args.in[8]; const float* ln1_g = args.in[12]; const float* ln1_b = args.in[13];
    const float* rg_w = args.in[14]; const float* rg_b = args.in[15]; const float* re_w = args.in[16]; const float* re_b = args.in[17];
    const float* ple_gate_b = args.in[23]; const float* ln2_g = args.in[24]; const float* ln2_b = args.in[25];
#define Wi8 ((bf16_t*)(ws + WS_WI))
#define Wib ((bf16_t*)(ws + WS_WI + 4 * MiB))
#define XF8 ((unsigned char*)(ws + WS_OV))
#define Wn ((bf16_t*)(ws + WS_WN))
#define Wo ((bf16_t*)(ws + WS_WO))
#define Wpg ((bf16_t*)(ws + WS_WPG))
#define Wpp ((bf16_t*)(ws + WS_WPP))
#define W1 ((bf16_t*)(ws + WS_W1))
#define W2 ((bf16_t*)(ws + WS_W2))
#define Wgu ((bf16_t*)(ws + WS_WGU))
#define Wd ((bf16_t*)(ws + WS_WD))
#define WRH ((bf16_t*)(ws + WS_WRH))
#define WRL ((bf16_t*)(ws + WS_WRL))
#define PB ((bf16_t*)(ws + WS_PB))
#define HM ((bf16_t*)(ws + WS_HM))
#define Z ((bf16_t*)(ws + WS_Z))
#define ZG8 ((unsigned char*)(ws + WS_ZG8))
#define XB ((bf16_t*)(ws + WS_XB))
#define OV ((bf16_t*)(ws + WS_OV))
#define T1 ((bf16_t*)(ws + WS_T1))
#define X1ST ((float*)(ws + WS_X1B))
#define X1F8 ((unsigned char*)(ws + WS_XS))
#define PLEB ((bf16_t*)(ws + WS_PLE))
#define T2F8 ((unsigned char*)(ws + WS_ZG8))
#define YS ((bf16_t*)(ws + WS_YS))
#define HS ((bf16_t*)args.out)
#define H1 ((bf16_t*)args.out + (size_t)64 * 1024 * 1024)
#define b1f ((float*)(ws + WS_B1F))
#define cnt ((unsigned*)(ws + WS_CNT))
#define meta ((unsigned*)(ws + WS_META))
#define perm ((int*)(ws + WS_PERM))
#define route ((unsigned*)(ws + WS_ROUTE))
#define tokslot ((int*)(ws + WS_TOKSLOT))
#define wslot ((float*)(ws + WS_WSLOT))
    const int RPB = (M + F.G - 1) / F.G;

    if (IN(0)) {
        int plane = lane_id(); asm volatile("" : "+v"(plane)); const int ptid = F.wave * 64 + plane; (void)ptid;
        LAS float* scr = (LAS float*)(ring + F.wave * 16384);
        constexpr int I_WI = 16 * 160, I_WN = 8 * 32, I_WO = 16 * 32, I_PP = 4 * 32, I_W1 = 2 * 128, I_W2 = 2 * 4, I_EX = 32 * 128;
        constexpr int NITEMS = I_WI + 2 * I_WN + 2 * I_WO + I_PP + I_W1 + I_W2 + 3 * I_EX;
        for (int it = gw; it < NITEMS; it += NGW) {
            int r = it;
            if (r < 640) { p0_tr_item(w_in, 1024, NHM, 40, Wi8, 1, 0, 512, C2, scr, r, plane, 0, 0, 1, NZ); continue; } r -= 640;
            if (r < 1024) { p0_tr_item(w_in + 2840, 1024, 2048, 64, Wi8, 1, NHM, 0, 1.f, scr, r, plane, 0, 0, 1, NZ); continue; } r -= 1024;
            if (r < 256) { p0_tr_item(w_in + NHM + 24, 1024, 512, 16, Wib, 1, 0, 0, 1.f, scr, r, plane, 0, 0, 0, NZ); continue; } r -= 256;
            if (r < 256) { p0_tr_item(w_in + NHM + 536, 1024, 512, 16, Wib, 2, 512, 0, 1.f, scr, r, plane, 0, 0, 0, NZ); continue; } r -= 256;
            if (r < 256) { p0_tr_item(w_in + NHM + 1048, 1024, 512, 16, Wib, 2, 513, 0, 1.f, scr, r, plane, 0, 0, 0, NZ); continue; } r -= 256;
            if (r < 128) { p0_tr_item(w_in + NHM, 1024, 24, 8, Wi8, 1, NHM + ZGP, 0, 1.f, scr, r, plane, 0, 0, 1, NZ); continue; } r -= 128;
            if (r < I_WN) { p0_tr_item(args.in[9], 512, 1024, 32, Wn, 1, 0, 0, 1.f, scr, r, plane, 1024, 0); continue; } r -= I_WN;
            if (r < I_WN) { p0_tr_item(args.in[10], 512, 1024, 32, Wn, 1, 0, 0, 1.f, scr, r, plane, 1024, 512); continue; } r -= I_WN;
            if (r < I_WO) { p0_tr_item(args.in[11], 1024, 1024, 32, Wo, 1, 0, 0, 1.f, scr, r, plane); continue; } r -= I_WO;
            if (r < I_WO) { p0_tr_item(args.in[22], 1024, 1024, 32, Wpg, 1, 0, 0, 1.f, scr, r, plane, 0, 0, 1); continue; } r -= I_WO;
            if (r < I_PP) { p0_tr_item(args.in[21], 256, 1024, 32, Wpp, 1, 0, 0, 1.f, scr, r, plane); continue; } r -= I_PP;
            if (r < I_W1) { const int kv = r / 128; p0_tr_item(args.in[4] + (size_t)kv * 2048 * 128, 2048, 128, 4, W1 + (size_t)kv * 128 * 2048, 1, 0, 0, 1.f, scr, r % 128, plane); continue; } r -= I_W1;
            if (r < I_W2) { const int kv = r / 4; p0_tr_item(args.in[6] + (size_t)kv * 128 * 64, 128, 64, 2, W2 + (size_t)kv * 64 * 128, 1, 0, 0, 1.f, scr, r % 4, plane); continue; } r -= I_W2;
            if (r < I_EX) { const int e = r / 128; p0_tr_item(args.in[18] + (size_t)e * 1024 * 256, 1024, 256, 8, (bf16_t*)((unsigned char*)Wgu + (size_t)e * 512 * 1024), 2, 0, 0, 1.f, scr, r % 128, plane, 0, 0, 1); continue; } r -= I_EX;
            if (r < I_EX) { const int e = r / 128; p0_tr_item(args.in[19] + (size_t)e * 1024 * 256, 1024, 256, 8, (bf16_t*)((unsigned char*)Wgu + (size_t)e * 512 * 1024), 2, 1, 0, 1.f, scr, r % 128, plane, 0, 0, 1); continue; } r -= I_EX;
            { const int e = r / 128; p0_tr_item(args.in[20] + (size_t)e * 256 * 1024, 256, 1024, 32, (bf16_t*)((unsigned char*)Wd + (size_t)e * 1024 * 256), 1, 0, 0, 1.f, scr, r % 128, plane, 0, 0, 1); }
        }
        for (long ch = (long)gw * 4; ch < (long)M * DM / 512; ch += (long)NGW * 4) { f32x4 a[4], b[4];
#pragma unroll
            for (int u = 0; u < 4; ++u) { const float* sp = x + (ch + u) * 512 + plane * 8; a[u] = __builtin_nontemporal_load((const f32x4*)sp); b[u] = __builtin_nontemporal_load((const f32x4*)(sp + 4)); }
#pragma unroll
            for (int u = 0; u < 4; ++u) { *(u32x4*)(XB + (ch + u) * 512 + plane * 8) = pack8(a[u], b[u]);
                u32x2 o8; o8.x = (unsigned)pack4_fp8(a[u][0], a[u][1], a[u][2], a[u][3]); o8.y = (unsigned)pack4_fp8(b[u][0], b[u][1], b[u][2], b[u][3]); *(u32x2*)(XF8 + (ch + u) * 512 + plane * 8) = o8; } }
        for (long ch = (long)gw * 4; ch < (long)M * PLE / 512; ch += (long)NGW * 4) { f32x4 a[4], b[4];
#pragma unroll
            for (int u = 0; u < 4; ++u) { const float* sp = p_in + (ch + u) * 512 + plane * 8; a[u] = __builtin_nontemporal_load((const f32x4*)sp); b[u] = __builtin_nontemporal_load((const f32x4*)(sp + 4)); }
#pragma unroll
            for (int u = 0; u < 4; ++u) *(u32x4*)(PB + (ch + u) * 512 + plane * 8) = pack8(a[u], b[u]); }
        for (int idx = gw * 64 + plane; idx < 64 * 1024; idx += NGW * 64) { const int c = idx >> 10, k = idx & 1023;
            const float w = c < 32 ? re_w[k * 32 + c] : (c < 36 ? rg_w[k * 4 + (c - 32)] : 0.f);
            const unsigned h = cvtpk(w, 0.f) & 0xffffu; const float wl = w - __uint_as_float(h << 16);
            const int di = (((((k >> 7) * 8 + ((k >> 4) & 7)) * 2 + (c >> 5)) * 64 + ((k >> 3) & 1) * 32 + (c & 31)) << 3) + (k & 7);
            WRH[di] = (bf16_t)h; WRL[di] = (bf16_t)(cvtpk(wl, 0.f) & 0xffffu); }
        for (int o = gw; o < 256; o += NGW) { const int kv = o >> 7, j = o & 127; const float* pe = args.in[3] + kv * 2048; const float* w1 = args.in[4] + (size_t)kv * 2048 * 128;
            float pv_[32], wv_[32];
#pragma unroll
            for (int i = 0; i < 32; ++i) { const int k = plane + 64 * i; pv_[i] = pe[k]; wv_[i] = w1[(size_t)k * 128 + j]; }
            float s = 0.f;
#pragma unroll
            for (int i = 0; i < 32; ++i) s += pv_[i] * wv_[i];
            s = wave_sum(s); if (plane == 0) b1f[o] = s + args.in[5][o]; }
    }
    SEAM(0);

    if (IN(1)) {
        { pg8::Gemm g{(const bf16_t*)XF8, Wi8, DM / 2, DM / 2, DM / 2}; pg8::GridOrder S; S.init(M, NHM + ZGP + 256, F.G, (int)blockIdx.x);
          pg8::EpiInProj8 E{HM, ZG8, Z};
          pg8::gemm_phase<pg8::EpiInProj8, pg8::GridOrder, false, false, true>(ring, g, S, E, F.wave); }
        { pg8::Gemm g{XB, Wib, DM, DM, DM}; pg8::GridOrder S; S.init(M, NZB, F.G, (int)blockIdx.x);
          pg8::EpiInProjZ E{Z};
          pg8::gemm_phase(ring, g, S, E, F.wave); }
    }
    SEAM(1);

    if (IN(2)) {
        int plane = lane_id(); asm volatile("" : "+v"(plane)); const int ptid = F.wave * 64 + plane; (void)ptid;
        for (int item = F.vcu; item < 256; item += F.G) att::compress_pair(item, HM, W1, W2, b1f, args.in[7], (bf16_t*)(ws + WS_KC), ring, F.wave, plane);
        const int c0 = plane * 8;
        f32x4 w0a = *(const f32x4*)(conv_w + c0), w0b = *(const f32x4*)(conv_w + c0 + 4), w1a = *(const f32x4*)(conv_w + 512 + c0), w1b = *(const f32x4*)(conv_w + 512 + c0 + 4),
              w2a = *(const f32x4*)(conv_w + 1024 + c0), w2b = *(const f32x4*)(conv_w + 1024 + c0 + 4);
        for (int ch = gw; ch < M / 32; ch += NGW) {
            const int m0 = ch * 32; const int t0 = m0 % SEQ;
            f32x4 ua1 = {0.f, 0.f, 0.f, 0.f}, ub1 = ua1, ua2 = ua1, ub2 = ua1;
            if (t0 != 0) {
                unpack8(*(const u32x4*)(Z + (size_t)(m0 - 1) * ZP + C_U + c0), ua1, ub1);
                unpack8(*(const u32x4*)(Z + (size_t)(m0 - 2) * ZP + C_U + c0), ua2, ub2);
            }
#pragma unroll 1
            for (int i0 = 0; i0 < 32; i0 += 8) {
                u32x4 ru[8], rb[8];
#pragma unroll
                for (int j = 0; j < 8; ++j) { const size_t zr = (size_t)(m0 + i0 + j) * ZP; ru[j] = *(const u32x4*)(Z + zr + C_U + c0); rb[j] = *(const u32x4*)(Z + zr + C_CB + c0); }
                asm volatile("" ::: "memory");
#pragma unroll
                for (int j = 0; j < 8; ++j) {
                    f32x4 ua, ub, ba, bb; unpack8(ru[j], ua, ub); unpack8(rb[j], ba, bb);
                    const f32x4 ya = ba * (w0a * ua2 + w1a * ua1 + w2a * ua), yb = bb * (w0b * ub2 + w1b * ub1 + w2b * ub);
                    *(u32x4*)(OV + (size_t)(m0 + i0 + j) * DM + 512 + c0) = pack8(ya, yb);
                    ua2 = ua1; ub2 = ub1; ua1 = ua; ub1 = ub;
                }
            }
        }
    }
    SEAM(2);
    if (IN(3)) {
        using namespace att;
        const int wid = F.wave, hh = wid >> 1, qs = wid & 1;
        const unsigned lds0 = (unsigned)(size_t)ring;
        LAS float* IMPG = (LAS float*)(ring + L_IMPG); LAS float* IMPL = (LAS float*)(ring + L_IMPL); LAS float* SC = (LAS float*)(ring + L_SC);
        LAS unsigned* SELM = (LAS unsigned*)(ring + L_SELM); LAS unsigned* UNI = (LAS unsigned*)(ring + L_UNI);
                const int nun = (F.G == 256) ? 8 : (2048 - F.vcu + F.G - 1) / F.G;
        for (int ui = 0; ui < nun; ++ui) {
            unsigned char* ws = args.ws; asm volatile("" : "+s"(ws));
            int bg, qt;
            if (F.G == 256) { bg = F.vcu >> 2; const int s_ = F.vcu & 3; qt = (ui & 1) ? 8 * (ui >> 1) + 7 - s_ : 8 * (ui >> 1) + s_; }
            else { const int u_ = F.vcu + ui * F.G; bg = u_ >> 5; qt = u_ & 31; }
            const int b = bg >> 1, g = bg & 1, head = 4 * g + hh, ntc = (qt >= 16) ? 2 : 1;
            const unsigned upto = (2u << qt) - 1u;
            const bf16_t* hb = HM + (size_t)(g * BATCH + b) * SEQ * 64;
            constexpr size_t HSL = (size_t)BATCH * SEQ * 64;
#define LANE_CTX int lane = lane_id(); const int r32 = lane & 31, hi = lane >> 5, ql = 32 * qs + r32, t = 64 * qt + ql; (void)t; \
            const int vrow_ = 4 * hi + ((lane & 15) >> 2); const unsigned vtr = (unsigned)(vrow_ * 128 + ((((lane >> 4) & 1) ^ (vrow_ & 2)) << 5) + (lane & 3) * 8); (void)vtr; \
            LAS float* wsf = (LAS float*)(ring + L_WSF) + wid * 64; (void)wsf; \
            LAS float* ocb = (LAS float*)(ring + L_IMPG) + wid * 2048; LAS float* gst = (LAS float*)(ring + L_K + 24576) + wid * 256 + lane; (void)gst;
#define LOAD_Q(qv) do { const bf16_t* qp_ = HM + ((size_t)((HS_Q + head) * BATCH + b) * SEQ + t) * 64 + hi * 8; _Pragma("unroll") for (int d0 = 0; d0 < 4; ++d0) qv[d0] = *(const bf16x8*)(qp_ + d0 * 16); } while (0)
            bf16x8 qr[4];
            unsigned uni; int rot = 0;
            {
            LANE_CTX; const int tid_ = wid * 64 + lane; const size_t mrow = (size_t)b * SEQ + t;
            { const bf16_t* kcb = (const bf16_t*)(ws + WS_KC) + (size_t)bg * 128 * 64; const bf16_t* vcb = (const bf16_t*)(ws + WS_VC) + (size_t)bg * 128 * 64;
              dma_kv(kcb, vcb, 0, lds0 + L_K, lds0 + L_V, wid, lane);
              if (ntc == 2) dma_kv(kcb, vcb, 1, lds0 + L_K + 8192, lds0 + L_V + 8192, wid, lane); }
            LOAD_Q(qr);
            const bf16_t* gp = Z + mrow * ZP + C_GN + head * 3;
            const float gate0 = sigm(bflo((unsigned)gp[0]));
            gst[0] = sigm(bflo((unsigned)gp[1])); gst[64] = sigm(bflo((unsigned)gp[2]));
            f32x16 ocomb[2];
            __syncthreads();
            if (tid_ < 64) SELM[tid_] = 0u;
            if (tid_ == 64) UNI[0] = 0u;
            VM_WAIT(); __syncthreads();
            {
                f32x16 a0, a1, b0, b1;
                qkt(a0, a1, ring + L_K, qr, r32, hi);
                if (ntc == 2) qkt(b0, b1, ring + L_K + 8192, qr, r32, hi); else { for (int i = 0; i < 16; ++i) { b0[i] = NEG; b1[i] = NEG; } }
                const int nmax = (t - 31) >> 4;
#pragma unroll
                for (int r = 0; r < 16; ++r) { const int kl = crow(r, hi);
                    a0[r] = (kl > nmax) ? NEG : a0[r]; a1[r] = (kl + 32 > nmax) ? NEG : a1[r]; b0[r] = (kl + 64 > nmax) ? NEG : b0[r]; b1[r] = (kl + 96 > nmax) ? NEG : b1[r]; }
                const float rm = __builtin_fmaxf(rowmax32(a0, a1), rowmax32(b0, b1));
                const bool anyv = nmax >= 0;
                float sum = 0.f;
#pragma unroll
                for (int r = 0; r < 16; ++r) { a0[r] = anyv ? __builtin_amdgcn_exp2f(a0[r] - rm) : 0.f; a1[r] = anyv ? __builtin_amdgcn_exp2f(a1[r] - rm) : 0.f;
                    b0[r] = anyv ? __builtin_amdgcn_exp2f(b0[r] - rm) : 0.f; b1[r] = anyv ? __builtin_amdgcn_exp2f(b1[r] - rm) : 0.f; sum += (a0[r] + a1[r]) + (b0[r] + b1[r]); }
                const float lt = half_swap_sum(sum); const float inv = lt > 0.f ? 1.f / lt : 0.f;
#pragma unroll
                for (int r = 0; r < 16; ++r) { a0[r] *= inv; a1[r] *= inv; b0[r] *= inv; b1[r] *= inv; }
                LAS float* ig = IMPG + (hh * 64 + ql) * 33; LAS float* il = IMPL + (hh * 64 + ql) * 33 + 1;
                if (hi == 0) il[-1] = 0.f;
#pragma unroll
                for (int rg = 0; rg < 4; ++rg) { const int mm = 2 * rg + hi;
                    ig[mm] = (a0[4 * rg] + a0[4 * rg + 1]) + (a0[4 * rg + 2] + a0[4 * rg + 3]); il[mm] = a0[4 * rg + 3];
                    ig[mm + 8] = (a1[4 * rg] + a1[4 * rg + 1]) + (a1[4 * rg + 2] + a1[4 * rg + 3]); il[mm + 8] = a1[4 * rg + 3];
                    ig[mm + 16] = (b0[4 * rg] + b0[4 * rg + 1]) + (b0[4 * rg + 2] + b0[4 * rg + 3]); il[mm + 16] = b0[4 * rg + 3];
                    ig[mm + 24] = (b1[4 * rg] + b1[4 * rg + 1]) + (b1[4 * rg + 2] + b1[4 * rg + 3]); if (mm + 24 < 31) il[mm + 24] = b1[4 * rg + 3]; }
                f32x16 oc[2]; for (int i = 0; i < 16; ++i) { oc[0][i] = 0.f; oc[1][i] = 0.f; }
                pv(oc, lds0 + L_V + vtr, packp(a0, 0), packp(a0, 8), packp(a1, 0), packp(a1, 8));
                if (ntc == 2) pv(oc, lds0 + L_V + 8192 + vtr, packp(b0, 0), packp(b0, 8), packp(b1, 0), packp(b1, 8));
                if (hi == 0) wsf[r32] = gate0;
                LDS_WAIT();
#pragma unroll
                for (int r = 0; r < 16; ++r) { const float f = wsf[crow(r, hi)]; ocomb[0][r] = oc[0][r] * f; ocomb[1][r] = oc[1][r] * f; }
            }
            __syncthreads();
            branch_prologue(hb + HS_KS * HSL, hb + HS_VS * HSL, qt, qt > 0 ? 0 : -1, lds0, wid, lane);
            { const int q = tid_ >> 3, sub = tid_ & 7;
              { const LAS float* pg = IMPG + q * 33 + 4 * sub; const LAS float* pl = IMPL + q * 33 + 4 * sub; f32x4 sv;
#pragma unroll
                for (int e = 0; e < 4; ++e) { const int mm = 4 * sub + e; float imp = 0.f;
#pragma unroll
                    for (int h = 0; h < 4; ++h) imp += pg[h * 64 * 33 + e] + pl[h * 64 * 33 + e];
                    const bool valid = mm <= qt, forced = (mm == 0) || (mm == qt) || (mm == qt - 1);
                    sv[e] = valid ? (imp + (forced ? 1e4f : 0.f)) : -1e4f; }
                *(LAS f32x4*)(SC + q * 36 + 4 * sub) = sv; }
              __syncthreads();
              { f32x4 sc[8];
#pragma unroll
                for (int k = 0; k < 8; ++k) sc[k] = *(const LAS f32x4*)(SC + q * 36 + 4 * k);
                unsigned bits = 0u;
#pragma unroll
                for (int e = 0; e < 4; ++e) { const int mm = 4 * sub + e; const float me_ = SC[q * 36 + mm]; int rank = 0;
#pragma unroll
                    for (int k = 0; k < 32; ++k) { const float o_ = sc[k >> 2][k & 3]; rank += (o_ > me_ || (o_ == me_ && k < mm)) ? 1 : 0; }
                    if (rank < 16) bits |= 1u << mm; }
                atomicOr((unsigned*)&SELM[q], bits); }
              __syncthreads();
              if (tid_ < 64) atomicOr((unsigned*)&UNI[0], SELM[tid_]);
              __syncthreads();
            }
                uni = (unsigned)__builtin_amdgcn_readfirstlane(UNI[0]) & upto;
#pragma unroll
                for (int r = 0; r < 16; ++r) { LAS float* p = ocb + crow(r, hi) * 64 + r32; p[0] = ocomb[0][r]; p[32] = ocomb[1][r]; }
            }
            {
                LANE_CTX; const unsigned selm = SELM[ql]; f32x16 ob[2]; float lb;
                run_branch_pipe<true, true, true>(ob, lb, uni | 1u | (1u << qt), selm, qt, -1, hb + HS_KS * HSL, hb + HS_VS * HSL, ring, lds0, qr, r32, hi, ql, wid, lane, vtr, wsf, rot);
                { int l2 = lane_id(); asm volatile("" : "+v"(l2));
                  fold_branch_lds(ocb, ob, lb, ((LAS float*)(ring + L_K + 24576) + wid * 256 + l2)[0], true, l2 & 31, l2 >> 5, wsf); } }
            {
                LANE_CTX; f32x16 ob[2]; float lb;
                const int j0 = qt >= 8 ? qt - 8 : 0; const unsigned wt = upto & ~((1u << j0) - 1u);
                run_branch_pipe<false, true, false>(ob, lb, wt, 0xffffffffu, qt, qt >= 8 ? qt - 8 : -1, hb + HS_KW * HSL, hb + HS_VW * HSL, ring, lds0, qr, r32, hi, ql, wid, lane, vtr, wsf, rot);
                { int l2 = lane_id(); asm volatile("" : "+v"(l2));
                  fold_branch_lds(ocb, ob, lb, ((LAS float*)(ring + L_K + 24576) + wid * 256 + l2)[64], true, l2 & 31, l2 >> 5, wsf); } }
            {
                LANE_CTX; LDS_WAIT();
                bf16_t* Ow = OV + ((size_t)b * SEQ + 64 * qt + 32 * qs) * DM + head * 64;
#pragma unroll
                for (int i = 0; i < 4; ++i) { const int row = i * 8 + (lane >> 3), ch = lane & 7; const f32x4 va = *(const LAS f32x4*)(ocb + row * 64 + ch * 8), vb_ = *(const LAS f32x4*)(ocb + row * 64 + ch * 8 + 4);
                    *(u32x4*)(Ow + (size_t)row * DM + ch * 8) = pack8(va, vb_); } }
#undef LANE_CTX
#undef LOAD_Q
        }
    }
    SEAM(3);

    if (IN(4)) {
        pg8::Gemm g{OV, Wn, DM, DM, DM}; pg8::GridOrder S; S.init(M, DM, F.G, (int)blockIdx.x);
        pg8::EpiMerge E{T1, ZG8};
        pg8::gemm_phase<pg8::EpiMerge, pg8::GridOrder, false, true>(ring, g, S, E, F.wave);
    }
    SEAM(4);
    if (IN(6)) {
        pg8::Gemm g{T1, Wo, DM, DM, DM}; pg8::GridOrder S; S.init(M, DM, F.G, (int)blockIdx.x);
        pg8::EpiResBf16 E{H1, XB};
        pg8::gemm_phase(ring, g, S, E, F.wave);
    }
    SEAM(6);

    if (IN(7)) {
        int plane = lane_id(); asm volatile("" : "+v"(plane)); const int ptid = F.wave * 64 + plane; (void)ptid;
        constexpr int XROW = 2064;
        LAS unsigned char* XH = ring;
        LAS float* RED = (LAS float*)ring;
        LAS float* LOG = (LAS float*)(ring + 16 * 64 * 33 * 4);
        static_assert(16 * 64 * 33 * 4 + 64 * 36 * 4 <= LDS_BYTES - RING_OFF, "P7 LDS map");
        LAS unsigned* hist = (LAS unsigned*)(F.lds + LDS_MISC + 256);
        if (ptid < 32) hist[ptid] = 0u;
        __syncthreads();
        const int mb = blockIdx.x * RPB, me = (mb + RPB < M) ? mb + RPB : M;
        const int r32 = plane & 31, hi = plane >> 5;
        f32x4 lg[4], lb[4];
#pragma unroll
        for (int j = 0; j < 4; ++j) { const int c = 4 * plane + 256 * j; lg[j] = *(const f32x4*)(ln1_g + c); lb[j] = *(const f32x4*)(ln1_b + c); }
        u32x2 raw[2][4][4];
#define P7_FETCH(mbase) do { _Pragma("unroll") for (int half = 0; half < 2; ++half) _Pragma("unroll") for (int rr = 0; rr < 4; ++rr) { const int m_ = (mbase) + F.wave * 8 + half * 4 + rr; const int mc = m_ < me ? m_ : me - 1; \
            const u32x2* hr = (const u32x2*)(H1 + (size_t)mc * DM) + plane; _Pragma("unroll") for (int j = 0; j < 4; ++j) raw[half][rr][j] = __builtin_nontemporal_load(hr + 64 * j); } } while (0)
        for (int m0 = mb; m0 < me; m0 += 64) {
            P7_FETCH(m0);
#pragma unroll
            for (int half = 0; half < 2; ++half) { f32x4 v[4][4];
#pragma unroll
              for (int rr = 0; rr < 4; ++rr) {
#pragma unroll
                  for (int j = 0; j < 4; ++j) { const u32x2 w = raw[half][rr][j]; v[rr][j] = (f32x4){bflo(w.x), bfhi(w.x), bflo(w.y), bfhi(w.y)}; } }
#pragma unroll
              for (int rr = 0; rr < 4; ++rr) { const int r = F.wave * 8 + half * 4 + rr, m = m0 + r; float s = 0.f;
#pragma unroll
                  for (int j = 0; j < 4; ++j) s += (v[rr][j][0] + v[rr][j][1]) + (v[rr][j][2] + v[rr][j][3]);
                  const float mean = wave_sum(s) * (1.f / DM); float s2 = 0.f;
#pragma unroll
                  for (int j = 0; j < 4; ++j) { v[rr][j] = v[rr][j] - mean; s2 += (v[rr][j][0] * v[rr][j][0] + v[rr][j][1] * v[rr][j][1]) + (v[rr][j][2] * v[rr][j][2] + v[rr][j][3] * v[rr][j][3]); }
                  const float rstd = 1.f / sqrtf(wave_sum(s2) * (1.f / DM) + LN_EPS);
                  if (plane == 0 && m < me) { f32x2 sv; sv[0] = mean; sv[1] = rstd; *(f32x2*)(X1ST + 2 * (size_t)m) = sv; }
#pragma unroll
                  for (int j = 0; j < 4; ++j) { const int c = 4 * plane + 256 * j;
                      const f32x4 y = v[rr][j] * rstd * lg[j] + lb[j];
                      u32x2 wh; wh.x = cvtpk(y[0], y[1]); wh.y = cvtpk(y[2], y[3]);
                      if (m < me) *(int*)(X1F8 + (size_t)m * DM + c) = pack4_fp8(y[0], y[1], y[2], y[3]);
                      *(LAS u32x2*)(XH + r * XROW + c * 2) = wh; } } }
            { att::f32x16 acc[2][2]; for (int i = 0; i < 16; ++i) { acc[0][0][i] = 0.f; acc[0][1][i] = 0.f; acc[1][0][i] = 0.f; acc[1][1][i] = 0.f; }
              int wo_ = F.wave * 8192 + plane * 8; asm volatile("" : "+v"(wo_));
              const bf16_t* wh0 = WRH + wo_; const bf16_t* wl0 = WRL + wo_;
              const LAS unsigned char* xh = XH + r32 * XROW + (128 * F.wave + 8 * hi) * 2;
              bf16x8 wf[4][4];
#pragma unroll
              for (int ks = 0; ks < 4; ++ks) { wf[ks][0] = *(const bf16x8*)(wh0 + ks * 1024); wf[ks][1] = *(const bf16x8*)(wh0 + ks * 1024 + 512); wf[ks][2] = *(const bf16x8*)(wl0 + ks * 1024); wf[ks][3] = *(const bf16x8*)(wl0 + ks * 1024 + 512); }
              asm volatile("" ::: "memory");
              __syncthreads();
#pragma unroll
              for (int kg = 0; kg < 2; ++kg) {
                  if (kg == 1) {
#pragma unroll
                      for (int ks = 0; ks < 4; ++ks) { wf[ks][0] = *(const bf16x8*)(wh0 + (ks + 4) * 1024); wf[ks][1] = *(const bf16x8*)(wh0 + (ks + 4) * 1024 + 512); wf[ks][2] = *(const bf16x8*)(wl0 + (ks + 4) * 1024); wf[ks][3] = *(const bf16x8*)(wl0 + (ks + 4) * 1024 + 512); }
                      asm volatile("" ::: "memory"); }
#pragma unroll
                  for (int k4 = 0; k4 < 4; ++k4) { const int ks = kg * 4 + k4;
                      const bf16x8 a0 = *(const LAS bf16x8*)(xh + ks * 32), a1 = *(const LAS bf16x8*)(xh + 32 * XROW + ks * 32);
                      const bf16x8 bh0 = wf[k4][0], bh1 = wf[k4][1], bl0 = wf[k4][2], bl1 = wf[k4][3];
                      acc[0][0] = MFMA32(a0, bh0, acc[0][0]); acc[0][0] = MFMA32(a0, bl0, acc[0][0]); acc[0][1] = MFMA32(a0, bh1, acc[0][1]); acc[0][1] = MFMA32(a0, bl1, acc[0][1]);
                      acc[1][0] = MFMA32(a1, bh0, acc[1][0]); acc[1][0] = MFMA32(a1, bl0, acc[1][0]); acc[1][1] = MFMA32(a1, bh1, acc[1][1]); acc[1][1] = MFMA32(a1, bl1, acc[1][1]); }
                  asm volatile("" ::: "memory");
              }
              __syncthreads();
#pragma unroll
              for (int rb = 0; rb < 2; ++rb)
#pragma unroll
                  for (int i = 0; i < 16; ++i) { const int row = 32 * rb + att::crow(i, hi); RED[((F.wave * 2 + 0) * 64 + row) * 33 + r32] = acc[rb][0][i]; RED[((F.wave * 2 + 1) * 64 + row) * 33 + r32] = acc[rb][1][i]; }
            }
            __syncthreads();
            { const int r = ptid & 63, og = ptid >> 6;
              for (int o = og; o < 36; o += 8) { const int cb = o >> 5, col = o & 31; float s = 0.f;
#pragma unroll
                  for (int w = 0; w < 8; ++w) s += RED[((w * 2 + cb) * 64 + r) * 33 + col];
                  LOG[r * 36 + o] = s; } }
            __syncthreads();
            if (ptid < 64 && m0 + ptid < me) {
                const int r = ptid, m = m0 + r; const LAS float* lgt = LOG + r * 36;
                float gl[4];
#pragma unroll
                for (int j = 0; j < 4; ++j) gl[j] = lgt[32 + j] + rg_b[j];
                float gmax = gl[0]; int gs = 0;
#pragma unroll
                for (int j = 1; j < 4; ++j) if (gl[j] > gmax) { gmax = gl[j]; gs = j; }
                float gsum = 0.f;
#pragma unroll
                for (int j = 0; j < 4; ++j) gsum += __expf(gl[j] - gmax);
                const float gtop = 1.f / gsum;
                float el[8];
#pragma unroll
                for (int j = 0; j < 8; ++j) el[j] = lgt[gs * 8 + j] + re_b[gs * 8 + j];
                float v0 = el[0]; int i0 = 0;
#pragma unroll
                for (int j = 1; j < 8; ++j) if (el[j] > v0) { v0 = el[j]; i0 = j; }
                float v1 = -3.0e38f; int i1 = 0;
#pragma unroll
                for (int j = 0; j < 8; ++j) if (j != i0 && el[j] > v1) { v1 = el[j]; i1 = j; }
                const float w0 = 1.f / (1.f + __expf(v1 - v0)), w1 = 1.f - w0;
                const unsigned e0 = (unsigned)(gs * 8 + i0), e1 = (unsigned)(gs * 8 + i1);
                const unsigned r0 = atomicAdd((unsigned*)&hist[e0], 1u), r1 = atomicAdd((unsigned*)&hist[e1], 1u);
                u32x4 rw; rw.x = e0 | (e1 << 8); rw.y = r0 | (r1 << 16); rw.z = __float_as_uint(w0 * gtop); rw.w = __float_as_uint(w1 * gtop);
                *(u32x4*)(route + (size_t)m * 4) = rw;
            }
            __syncthreads();
        }
        if (ptid < 32) cnt[blockIdx.x * 32 + ptid] = hist[ptid];
#undef P7_FETCH
    }
    SEAM(7);

    if (IN(8)) {
        int plane = lane_id(); asm volatile("" : "+v"(plane)); const int ptid = F.wave * 64 + plane; (void)ptid;
        LAS unsigned* PT = (LAS unsigned*)ring;
        LAS unsigned* PBf = PT + 512; LAS unsigned* TOT = PT + 1024; LAS unsigned* BEF = PT + 1056; LAS unsigned* SB = PT + 1088;
        { const int e = ptid & 31, part = ptid >> 5; unsigned tot = 0u, bef = 0u;
          unsigned cv_[16];
#pragma unroll
          for (int i = 0; i < 16; ++i) { const int j = part + 16 * i; cv_[i] = j < F.G ? cnt[j * 32 + e] : 0u; }
#pragma unroll
          for (int i = 0; i < 16; ++i) { const int j = part + 16 * i; tot += cv_[i]; if (j < (int)blockIdx.x) bef += cv_[i]; }
          for (int j = part + 256; j < F.G; j += 16) { const unsigned c = cnt[j * 32 + e]; tot += c; if (j < (int)blockIdx.x) bef += c; }
          PT[part * 32 + e] = tot; PBf[part * 32 + e] = bef; }
        __syncthreads();
        if (ptid < 32) { unsigned tot = 0u, bef = 0u;
#pragma unroll
            for (int q = 0; q < 16; ++q) { tot += PT[q * 32 + ptid]; bef += PBf[q * 32 + ptid]; }
            TOT[ptid] = tot; BEF[ptid] = bef; }
        __syncthreads();
        if (ptid < 32) { unsigned base = 0u, tp = 0u;
            for (int e = 0; e < ptid; ++e) { base += TOT[e]; tp += (TOT[e] + 255u) >> 8; }
            SB[ptid] = base + BEF[ptid];
            if (blockIdx.x == 0) { meta[ptid] = base; meta[32 + ptid] = TOT[ptid]; meta[64 + ptid] = tp; if (ptid == 31) meta[96] = tp + ((TOT[31] + 255u) >> 8); } }
        __syncthreads();
        const int mb = blockIdx.x * RPB, me = (mb + RPB < M) ? mb + RPB : M;
        for (int m = mb + ptid; m < me; m += NWAVES * 64) {
            const u32x4 rw = *(const u32x4*)(route + (size_t)m * 4);
            const unsigned s0 = SB[rw.x & 255u] + (rw.y & 0xffffu), s1 = SB[(rw.x >> 8) & 255u] + (rw.y >> 16);
            tokslot[2 * m] = (int)s0; tokslot[2 * m + 1] = (int)s1; wslot[s0] = __uint_as_float(rw.z); wslot[s1] = __uint_as_float(rw.w);
            perm[s0] = m; perm[s1] = m;
        }
        __syncthreads();
    }

    if (IN(9)) {
        pg8::Gemm g{PB, Wpp, PLE, PLE, PLE}; pg8::GridOrder S; S.init(M, DM, F.G, (int)blockIdx.x);
        pg8::EpiStoreFp8 E{T2F8};
        pg8::gemm_phase(ring, g, S, E, F.wave);
    }
    if (IN(10)) {
        pg8::Gemm g{(const bf16_t*)X1F8, Wpg, DM / 2, DM / 2, DM / 2}; pg8::GridOrder S; S.init(M, DM, F.G, (int)blockIdx.x);
        pg8::EpiPle E{PLEB, ple_gate_b, H1, T2F8, X1ST, ln1_g, ln1_b};
        pg8::gemm_phase<pg8::EpiPle, pg8::GridOrder, false, false, true>(ring, g, S, E, F.wave);
    }
    SEAM(10);

    struct MoeOrder {
        const LAS unsigned* mt; int G, c, cts, nb;
        __device__ __forceinline__ bool next(int i, pg8::Unit& u) const {
            const int L = i * G + c; const int tt = L / cts, ct = L % cts; const int TT = (int)mt[96];
            if (tt >= TT) return false;
            int e = 0;
            for (int q = 1; q < 32; ++q) if (tt >= (int)mt[64 + q]) e = q;
            const int rt = tt - (int)mt[64 + e]; const int base = (int)mt[e] + 256 * rt; const int nv = (int)mt[32 + e] - 256 * rt;
            u.arow = __builtin_amdgcn_readfirstlane(base); u.brow = __builtin_amdgcn_readfirstlane(e * nb + 256 * ct); u.orow = u.arow; u.ocol = __builtin_amdgcn_readfirstlane(256 * ct);
            u.nvalid = __builtin_amdgcn_readfirstlane(nv < 256 ? nv : 256); u.idx = i; return true;
        }
    };
    LAS unsigned* MT = (LAS unsigned*)(F.lds + LDS_MISC + 512);
    if (IN(11) || IN(12)) { const int ptid = F.wave * 64 + lane_id(); if (ptid < 97) MT[ptid] = meta[ptid]; __syncthreads(); }
    if (IN(11)) {
        pg8::Gemm g{(const bf16_t*)X1F8, Wgu, DM / 2, DM / 2, DM / 2}; MoeOrder S{MT, F.G, F.vcu, 2, 512};
        LAS unsigned* TAB = (LAS unsigned*)(ring + pg8::STAGE_BYTES);
        LAS float* WTAB = (LAS float*)(TAB + 6 * 256);
        static_assert(pg8::STAGE_BYTES + 2 * 6 * 256 * 4 <= LDS_BYTES - RING_OFF, "P11 LDS tables");
        { pg8::Unit u; const int ptid = F.wave * 64 + lane_id(); unsigned rows_[6]; float wts_[6]; int nu = 0;
#pragma unroll
          for (int i = 0; i < 6; ++i) { rows_[i] = 0u; wts_[i] = 0.f; if (S.next(i, u)) { nu = i + 1; if (ptid < u.nvalid && ptid < 256) { rows_[i] = (unsigned)perm[u.arow + ptid]; wts_[i] = wslot[u.arow + ptid]; } } }
          asm volatile("" ::: "memory");
#pragma unroll
          for (int i = 0; i < 6; ++i) if (i < nu && ptid < 256) { TAB[i * 256 + ptid] = rows_[i] * (unsigned)DM; WTAB[i * 256 + ptid] = wts_[i]; }
          __syncthreads(); }
        pg8::EpiSwiGlu E{(unsigned char*)HS, WTAB};
        pg8::gemm_phase<pg8::EpiSwiGlu, MoeOrder, true, false, true>(ring, g, S, E, F.wave, TAB);
    }
    SEAM(11);
    if (IN(12)) {
        int k12 = EH / 2; asm volatile("" : "+s"(k12));
        pg8::Gemm g{HS, Wd, EH / 2, EH / 2, k12}; MoeOrder S{MT, F.G, F.vcu, 4, 1024};
        pg8::EpiScaleRows E{(unsigned char*)YS};
        pg8::gemm_phase<pg8::EpiScaleRows, MoeOrder, false, false, true>(ring, g, S, E, F.wave);
    }
    SEAM(12);

    if (IN(13)) {
        int plane = lane_id(); asm volatile("" : "+v"(plane)); const int ptid = F.wave * 64 + plane; (void)ptid;
        const bool dead = (__hip_atomic_load(ctl + CW_BAR + XB_TMO, RLX_AGENT) != 0u);
        f32x4 lg[4], lb[4];
#pragma unroll
        for (int j = 0; j < 4; ++j) { const int c = 8 * plane + 512 * (j >> 1) + 4 * (j & 1); lg[j] = *(const f32x4*)(ln2_g + c); lb[j] = *(const f32x4*)(ln2_b + c); }
        int sl_[2][2];
#pragma unroll
        for (int rr = 0; rr < 2; ++rr) { const int m = gw * 2 + rr; sl_[rr][0] = m < M ? tokslot[2 * m] : 0; sl_[rr][1] = m < M ? tokslot[2 * m + 1] : 0; }
        for (int m2 = gw * 2; m2 < M; m2 += NGW * 2) {
            f32x4 v[2][4]; int nx_[2][2];
#pragma unroll
            for (int rr = 0; rr < 2; ++rr) { const int mn = m2 + NGW * 2 + rr; const int mc = mn < M ? mn : M - 1; nx_[rr][0] = tokslot[2 * mc]; nx_[rr][1] = tokslot[2 * mc + 1]; }
#pragma unroll
            for (int rr = 0; rr < 2; ++rr) { const int m = m2 + rr; const int s0 = sl_[rr][0], s1 = sl_[rr][1];
#pragma unroll
                for (int j = 0; j < 2; ++j) { const int c = 8 * plane + 512 * j;
                    f32x4 ya, yb, za, zb, pa, pb;
                    unpack8_fp8(__builtin_nontemporal_load((const u32x2*)((const unsigned char*)YS + (size_t)s0 * DM + c)), ya, yb);
                    unpack8_fp8(__builtin_nontemporal_load((const u32x2*)((const unsigned char*)YS + (size_t)s1 * DM + c)), za, zb); unpack8(__builtin_nontemporal_load((const u32x4*)(PLEB + (size_t)m * DM + c)), pa, pb);
                    v[rr][2 * j] = ya + za + pa; v[rr][2 * j + 1] = yb + zb + pb; } }
#pragma unroll
            for (int rr = 0; rr < 2; ++rr) { const int m = m2 + rr; float s = 0.f;
#pragma unroll
                for (int j = 0; j < 4; ++j) s += (v[rr][j][0] + v[rr][j][1]) + (v[rr][j][2] + v[rr][j][3]);
                const float mean = wave_sum(s) * (1.f / DM); float s2 = 0.f;
#pragma unroll
                for (int j = 0; j < 4; ++j) { v[rr][j] = v[rr][j] - mean; s2 += (v[rr][j][0] * v[rr][j][0] + v[rr][j][1] * v[rr][j][1]) + (v[rr][j][2] * v[rr][j][2] + v[rr][j][3] * v[rr][j][3]); }
                const float rstd = 1.f / sqrtf(wave_sum(s2) * (1.f / DM) + LN_EPS);
#pragma unroll
                for (int j = 0; j < 4; ++j) { const int c = 8 * plane + 512 * (j >> 1) + 4 * (j & 1);
                    f32x4 o = v[rr][j] * rstd * lg[j] + lb[j]; if (dead) { const float q = __builtin_nanf(""); o = (f32x4){q, q, q, q}; }
                    __builtin_nontemporal_store(o, (f32x4*)(args.out + (size_t)m * DM + c)); } }
#pragma unroll
            for (int rr = 0; rr < 2; ++rr) { sl_[rr][0] = nx_[rr][0]; sl_[rr][1] = nx_[rr][1]; }
        }
    }
#undef IN
#undef SEAM
}

#undef T2F8
#undef Wi8
#undef Wib
#undef XF8
#undef Wn
#undef Wo
#undef Wpg
#undef Wpp
#undef W1
#undef W2
#undef Wgu
#undef Wd
#undef WRH
#undef WRL
#undef PB
#undef HM
#undef Z
#undef ZG8
#undef XB
#undef OV
#undef T1
#undef X1ST
#undef X1F8
#undef PLEB
#undef YS
#undef HS
#undef H1
#undef b1f
#undef cnt
#undef meta
#undef perm
#undef route
#undef tokslot
#undef wslot
#ifndef MK_SPLIT
#define MK_SPLIT 0
#endif
constexpr int NPHASE = 14;
extern "C" void kernel_launch(void* const* d_in, const int* in_sizes, int n_in, void* d_out, int out_size, void* d_ws, size_t ws_size, hipStream_t stream) {
    static int grid = 0;
    if (grid == 0) {
        if (n_in != 26 || in_sizes[0] != M * DM || out_size != M * DM || ws_size < WS_END) { fprintf(stderr, "kernel_launch: unexpected shapes (n_in %d, in0 %d, out %d, ws %zu)\n", n_in, n_in > 0 ? in_sizes[0] : -1, out_size, ws_size); grid = -1; return; }
        int dev = 0, cus = 0, per_cu = 0;
        if (hipGetDevice(&dev) != hipSuccess || hipDeviceGetAttribute(&cus, hipDeviceAttributeMultiprocessorCount, dev) != hipSuccess) { grid = -1; return; }
        if (hipFuncSetAttribute((const void*)nsa_fwd, hipFuncAttributeMaxDynamicSharedMemorySize, LDS_BYTES) != hipSuccess) { fprintf(stderr, "kernel_launch: hipFuncSetAttribute failed\n"); grid = -1; return; }
        if (hipOccupancyMaxActiveBlocksPerMultiprocessor(&per_cu, (const void*)nsa_fwd, NWAVES * 64, LDS_BYTES) != hipSuccess || per_cu < 1) { fprintf(stderr, "kernel_launch: occupancy query reports %d\n", per_cu); }
        (void)hipGetLastError();
        grid = cus;
    }
    if (grid < 0) return;
    (void)hipMemsetAsync((char*)d_ws + WS_CTL, 0, CTL_ZERO_BYTES, stream);
    Args a{};
    for (int i = 0; i < 26; ++i) a.in[i] = (const float*)d_in[i];
    a.out = (float*)d_out; a.ws = (unsigned char*)d_ws;
#if MK_SPLIT
    for (int ph = 0; ph < NPHASE; ++ph) { a.ph_lo = ph; a.ph_hi = ph + 1; hipLaunchKernelGGL(nsa_fwd, dim3(grid), dim3(NWAVES * 64), LDS_BYTES, stream, a); }
#else
    a.ph_lo = 0; a.ph_hi = NPHASE;
    hipLaunchKernelGGL(nsa_fwd, dim3(grid), dim3(NWAVES * 64), LDS_BYTES, stream, a);
#endif
}
```

```cpp
#include <hip/hip_runtime.h>
#include <cstdio>
#include <cstdint>
#include <type_traits>

#define LAS __attribute__((address_space(3)))
#define GAS __attribute__((address_space(1)))
typedef unsigned short bf16_t;
typedef short bf16x8 __attribute__((ext_vector_type(8)));
typedef float f32x4 __attribute__((ext_vector_type(4)));
typedef float f32x2 __attribute__((ext_vector_type(2)));
typedef unsigned u32x4 __attribute__((ext_vector_type(4)));
typedef unsigned u32x2 __attribute__((ext_vector_type(2)));
typedef __bf16 bf16x2_t __attribute__((ext_vector_type(2)));
typedef int i32x4 __attribute__((ext_vector_type(4)));
typedef int i32x8 __attribute__((ext_vector_type(8)));
typedef GAS unsigned gu32;
#define RLX_AGENT __ATOMIC_RELAXED, __HIP_MEMORY_SCOPE_AGENT
#define LDS_WAIT() asm volatile("s_waitcnt lgkmcnt(0)" ::: "memory")
#define VM_WAIT() asm volatile("s_waitcnt vmcnt(0)" ::: "memory")

constexpr int BATCH = 32, SEQ = 2048, DM = 1024, M = BATCH * SEQ, PLE = 256;
constexpr int NZP = 5120, NZ = 4888;
constexpr int NHM = 1280;
constexpr int HS_Q = 0, HS_KC = 8, HS_VC = 10, HS_KS = 12, HS_VS = 14, HS_KW = 16, HS_VW = 18;
constexpr int NZB = 1536;
constexpr int ZP = 1088;
constexpr int C_CB = 0, C_U = 512, C_GN = 1024;
constexpr int ZGP = 2048, C_GMN = 0, C_GMC = 1024;
__host__ __device__ __forceinline__ size_t zg_off(int row, int col) { return ((size_t)(row >> 3) * (ZGP / 64) + (size_t)(col >> 6)) * 512 + (size_t)((row & 7) * 64 + (col & 63)); }
constexpr int NEXP = 32, EH = 256;
constexpr float LN_EPS = 1e-5f;
constexpr float ALPHA = 1.189207115002721f;
constexpr float C2 = 0.125f * 1.4426950408889634f;

constexpr size_t MiB = 1u << 20;
constexpr size_t WS_CTL = 0, CTL_ZERO_BYTES = 1 * MiB;
constexpr size_t WS_B1F = 1 * MiB;
constexpr size_t WS_CNT = 1 * MiB + 4096;
constexpr size_t WS_META = 1 * MiB + 4096 + 65536;
constexpr size_t WS_ROUTE = 2 * MiB;
constexpr size_t WS_TOKSLOT = 3 * MiB;
constexpr size_t WS_WSLOT = 3 * MiB + 512 * 1024;
constexpr size_t WS_PERM = 6 * MiB;
constexpr size_t WS_KC = 4 * MiB, WS_VC = 5 * MiB;
constexpr size_t WS_WI = 8 * MiB, WS_WN = 18 * MiB, WS_WC = 19 * MiB, WS_WO = 20 * MiB, WS_WPG = 22 * MiB, WS_WPP = 24 * MiB, WS_W1 = 25 * MiB, WS_W2 = 26 * MiB, WS_WGU = 28 * MiB, WS_WD = 60 * MiB;
constexpr size_t WS_WRH = 26 * MiB + 256 * 1024, WS_WRL = 26 * MiB + 512 * 1024;
constexpr size_t WS_PB = 76 * MiB;
constexpr size_t WS_Z = 108 * MiB;
constexpr size_t WS_ZG8 = 332 * MiB;
constexpr size_t WS_T1 = 460 * MiB;
constexpr size_t WS_HM = 588 * MiB;
constexpr size_t WS_X1B = 108 * MiB, WS_XS = 236 * MiB, WS_PLE = 494 * MiB;
constexpr size_t WS_XB = 748 * MiB;
constexpr size_t WS_OV = 876 * MiB;
constexpr size_t WS_YS = 748 * MiB;
constexpr size_t WS_END = 1005 * MiB;

constexpr int LDS_MISC = 0;
constexpr int RING_OFF = 1024;
constexpr int LDS_BYTES = 147456;
constexpr int NWAVES = 8;

__device__ __forceinline__ int lane_id() { int l; asm volatile("v_mbcnt_lo_u32_b32 %0, -1, 0\n\tv_mbcnt_hi_u32_b32 %0, -1, %0" : "=v"(l)); return l; }
__device__ __forceinline__ unsigned cvtpk(float lo, float hi) { f32x2 v = {lo, hi}; bf16x2_t b = __builtin_convertvector(v, bf16x2_t); return __builtin_bit_cast(unsigned, b); }
__device__ __forceinline__ int pack4_fp8(float a, float b, float c, float d) { int r = __builtin_amdgcn_cvt_pk_fp8_f32(a, b, 0, false); return __builtin_amdgcn_cvt_pk_fp8_f32(c, d, r, true); }
__device__ __forceinline__ void unpack8_fp8(const u32x2& w, f32x4& a, f32x4& b) { const f32x2 a0 = __builtin_amdgcn_cvt_pk_f32_fp8((int)w.x, false), a1 = __builtin_amdgcn_cvt_pk_f32_fp8((int)w.x, true), b0 = __builtin_amdgcn_cvt_pk_f32_fp8((int)w.y, false), b1 = __builtin_amdgcn_cvt_pk_f32_fp8((int)w.y, true);
    a = (f32x4){a0[0], a0[1], a1[0], a1[1]}; b = (f32x4){b0[0], b0[1], b1[0], b1[1]}; }
__device__ __forceinline__ float bflo(unsigned u) { return __uint_as_float(u << 16); }
__device__ __forceinline__ float bfhi(unsigned u) { return __uint_as_float(u & 0xffff0000u); }
__device__ __forceinline__ float sigm(float x) { return __builtin_amdgcn_rcpf(1.0f + __expf(-x)); }
__device__ __forceinline__ u32x4 pack8(const f32x4& a, const f32x4& b) { u32x4 w; w.x = cvtpk(a[0], a[1]); w.y = cvtpk(a[2], a[3]); w.z = cvtpk(b[0], b[1]); w.w = cvtpk(b[2], b[3]); return w; }
__device__ __forceinline__ void unpack8(const u32x4& w, f32x4& a, f32x4& b) { a = (f32x4){bflo(w.x), bfhi(w.x), bflo(w.y), bfhi(w.y)}; b = (f32x4){bflo(w.z), bfhi(w.z), bflo(w.w), bfhi(w.w)}; }

namespace pg8 {
constexpr int BM = 256, BK = 64, HALF = 128, HTB = HALF * BK * 2, STAGE_BYTES = 8 * HTB, NXCD = 8, WGM = 8;
__host__ __device__ __forceinline__ int lds_swz(int r) { return r & 7; }
__host__ __device__ __forceinline__ int lds_byte(int r, int c) { return r * 128 + (((c >> 3) ^ lds_swz(r)) << 4) + (c & 7) * 2; }
__host__ __device__ __forceinline__ void stage_rc(int b, int& R, int& C) { R = b >> 7; C = ((((b >> 4) & 7) ^ lds_swz(R)) << 3); }
__host__ __device__ __forceinline__ int perm32(int rho) { const int n = rho >> 4, i = rho & 15; return 8 * (i >> 2) + 4 * n + (i & 3); }

struct Unit { int arow, brow, orow, ocol, nvalid, idx; };
struct Gemm { const bf16_t* A; const bf16_t* Bt; int lda, ldb, K; };

struct GridOrder {
    int nM, nN, nwg, G, c;
    __device__ void init(int M_, int N_, int G_, int c_) { nM = M_ / BM; nN = N_ / BM; nwg = nM * nN; G = G_; c = c_; }
    __device__ __forceinline__ bool next(int i, Unit& u) const {
        const long L = (long)i * G + c; if (L >= nwg) return false;
        int wgid = (int)L; { const int q = nwg / NXCD, r = nwg % NXCD, xcd = wgid % NXCD, off = wgid / NXCD; wgid = (xcd < r ? xcd * (q + 1) : r * (q + 1) + (xcd - r) * q) + off; }
        const int nig = WGM * nN, gid = wgid / nig, fm = gid * WGM, gsz = (nM - fm) < WGM ? (nM - fm) : WGM;
        const int pm = fm + ((wgid % nig) % gsz), pn = (wgid % nig) / gsz;
        u.arow = pm * BM; u.brow = pn * BM; u.orow = pm * BM; u.ocol = pn * BM; u.nvalid = BM; u.idx = i; return true;
    }
};

__device__ __forceinline__ void pg8_dma(const void* sbase_, unsigned voff, unsigned lds_dst) { unsigned keep;
    const unsigned long long sb_ = (unsigned long long)sbase_;
    const unsigned long long sbase = ((unsigned long long)(unsigned)__builtin_amdgcn_readfirstlane((int)(sb_ >> 32)) << 32) | (unsigned)__builtin_amdgcn_readfirstlane((int)sb_);
    asm volatile("s_mov_b32 %0, m0\n\ts_mov_b32 m0, %3\n\ts_nop 0\n\tglobal_load_lds_dwordx4 %1, %2\n\ts_mov_b32 m0, %0" : "=&s"(keep) : "v"(voff), "s"(sbase), "s"(lds_dst) : "memory"); }
__device__ __forceinline__ i32x8 pg8_cat(i32x4 a, i32x4 b) { return __builtin_shufflevector(a, b, 0, 1, 2, 3, 4, 5, 6, 7); }
template <class T> __device__ __forceinline__ T pg8_ld16(const LAS unsigned char* p);
template <> __device__ __forceinline__ bf16x8 pg8_ld16<bf16x8>(const LAS unsigned char* p) { return *(const LAS bf16x8*)p; }
template <> __device__ __forceinline__ i32x8 pg8_ld16<i32x8>(const LAS unsigned char* p) { (void)p; return i32x8{}; }
__device__ __forceinline__ f32x4 pg8_mma16(bf16x8 w, bf16x8 x, f32x4 c) { return __builtin_amdgcn_mfma_f32_16x16x32_bf16(w, x, c, 0, 0, 0); }
__device__ __forceinline__ f32x4 pg8_mma16(i32x8, i32x8, f32x4 c) { return c; }
__device__ __forceinline__ f32x4 pg8_mma8(i32x8 w, i32x8 x, f32x4 c) { return __builtin_amdgcn_mfma_scale_f32_16x16x128_f8f6f4(w, x, c, 0, 0, 0, 0x7a7a7a7a, 0, 0x7f7f7f7f); }
__device__ __forceinline__ f32x4 pg8_mma8(bf16x8, bf16x8, f32x4 c) { return c; }
template <class Epi, class Sched, bool GATHER = false, bool MIDK = false, bool FP8 = false>
__device__ __forceinline__ void gemm_phase(LAS unsigned char* lds, const Gemm g, const Sched& S, const Epi& E, int wave_, const LAS unsigned* tab = nullptr) {
    int lane = lane_id(); asm volatile("" : "+v"(lane));
    const int wid = wave_, tid = wid * 64 + lane, wr = wid >> 2, wc = wid & 3, fr = lane & 15, fq = lane >> 4;
    const int K = g.K, nt = K / BK;
    unsigned voffA[2], voffB[2], tabA[2];
#pragma unroll
    for (int i = 0; i < 2; ++i) { int R, C; stage_rc(tid * 16 + i * 8192, R, C); const int Rb = (R & ~31) + perm32(R & 31);
        voffA[i] = GATHER ? (unsigned)C * 2u : (unsigned)(R * g.lda + C) * 2u; tabA[i] = (unsigned)R; voffB[i] = (unsigned)(Rb * g.ldb + C) * 2u; }
    const size_t kstep = (size_t)(BK * 2);
    const size_t hstepA = (size_t)HALF * g.lda * 2, hstepB = (size_t)HALF * g.ldb * 2;
    const unsigned ldsw = (unsigned)wid * 1024u; const unsigned lds32 = (unsigned)(size_t)lds + ldsw;
    const int aoff = lds_byte(wr * 64 + fr, fq * 8), boff = (wc >> 1) * HTB + lds_byte((wc & 1) * 64 + fr, fq * 8);
    const int aoff1 = lds_byte(wr * 64 + fr, 32 + fq * 8), boff1 = (wc >> 1) * HTB + lds_byte((wc & 1) * 64 + fr, 32 + fq * 8);
    LAS unsigned char* ldsA = lds + aoff; LAS unsigned char* ldsB = lds + 4 * HTB + boff; LAS unsigned char* ldsA1 = lds + aoff1; LAS unsigned char* ldsB1 = lds + 4 * HTB + boff1;
    asm volatile("" : "+v"(ldsA), "+v"(ldsB), "+v"(ldsA1), "+v"(ldsB1));
#define PG8_SA(b, h) (((b) * 2 + (h)) * HTB)
#define PG8_SB(b, h) ((4 + (b) * 2 + (h)) * HTB)
#define PG8_STAGE(bufoff, gbase, voff) do { _Pragma("unroll") for (int _i = 0; _i < 2; ++_i) \
        pg8_dma((const char*)(gbase), (voff)[_i], lds32 + (unsigned)((bufoff) + _i * 8192)); } while (0)
#define PG8_STAGE_A(bufoff, h, nx, koff) do { if (GATHER) { _Pragma("unroll") for (int _i = 0; _i < 2; ++_i) { const unsigned ro_ = tab[(ui + (nx)) * 256 + (h) * HALF + tabA[_i]]; \
        pg8_dma((const char*)g.A + (size_t)(koff), ro_ + voffA[_i], lds32 + (unsigned)((bufoff) + _i * 8192)); } } \
        else { PG8_STAGE(bufoff, ((nx) ? nA : cA) + (size_t)(h) * hstepA + (koff), voffA); } } while (0)
#define PG8_LDA(dst, b, h) do { _Pragma("unroll") for (int m = 0; m < 4; ++m) { if constexpr (FP8) { const i32x4 l0_ = *(const LAS i32x4*)(ldsA + PG8_SA(b, h) + m * 2048), l1_ = *(const LAS i32x4*)(ldsA1 + PG8_SA(b, h) + m * 2048); \
            dst[m][0] = pg8_cat(l0_, l1_); } else { _Pragma("unroll") for (int k = 0; k < 2; ++k) dst[m][k] = pg8_ld16<frag_t>((k ? ldsA1 : ldsA) + PG8_SA(b, h) + m * 2048); } } } while (0)
#define PG8_LDB(dst, b, h) do { _Pragma("unroll") for (int n = 0; n < 2; ++n) { if constexpr (FP8) { const i32x4 l0_ = *(const LAS i32x4*)(ldsB + (PG8_SB(b, 0) - 4 * HTB) + (h) * 4096 + n * 2048), l1_ = *(const LAS i32x4*)(ldsB1 + (PG8_SB(b, 0) - 4 * HTB) + (h) * 4096 + n * 2048); \
            dst[n][0] = pg8_cat(l0_, l1_); } else { _Pragma("unroll") for (int k = 0; k < 2; ++k) dst[n][k] = pg8_ld16<frag_t>((k ? ldsB1 : ldsB) + (PG8_SB(b, 0) - 4 * HTB) + (h) * 4096 + n * 2048); } } } while (0)
#define PG8_MMA(ai, bj, At, Bt) do { if constexpr (FP8) __builtin_amdgcn_sched_barrier(0);     \
        __builtin_amdgcn_s_setprio(1); \
        _Pragma("unroll") for (int m = 0; m < 4; ++m) _Pragma("unroll") for (int n = 0; n < 2; ++n) { \
            if constexpr (FP8) acc[ai][bj][m][n] = pg8_mma8(Bt[n][0], At[m][0], acc[ai][bj][m][n]); \
            else { _Pragma("unroll") for (int k = 0; k < 2; ++k) acc[ai][bj][m][n] = pg8_mma16(Bt[n][k], At[m][k], acc[ai][bj][m][n]); } } \
        __builtin_amdgcn_s_setprio(0); \
        if constexpr (FP8) { asm volatile("" : "+v"(acc[ai][bj][0][0]), "+v"(acc[ai][bj][0][1]), "+v"(acc[ai][bj][1][0]), "+v"(acc[ai][bj][1][1]), "+v"(acc[ai][bj][2][0]), "+v"(acc[ai][bj][2][1]), "+v"(acc[ai][bj][3][0]), "+v"(acc[ai][bj][3][1])); \
            __builtin_amdgcn_sched_barrier(0); } } while (0)
#define PG8_WAIT_V(n) asm volatile("s_waitcnt vmcnt(" #n ")" ::: "memory")
#define PG8_WAIT_L(n) asm volatile("s_waitcnt lgkmcnt(" #n ")" ::: "memory")
#define PG8_BAR __builtin_amdgcn_s_barrier()
#define PG8_SCHED __builtin_amdgcn_sched_barrier(0)
    Unit cur, nxt; int ui = 0;
    if (!S.next(0, cur)) return;
    f32x4 acc[2][2][4][2];
#pragma unroll
    for (int a = 0; a < 2; ++a)
#pragma unroll
        for (int b = 0; b < 2; ++b)
#pragma unroll
            for (int m = 0; m < 4; ++m)
#pragma unroll
                for (int n = 0; n < 2; ++n) acc[a][b][m][n] = (f32x4){0.f, 0.f, 0.f, 0.f};
    typedef typename std::conditional<FP8, i32x8, bf16x8>::type frag_t;
    frag_t At[4][FP8 ? 1 : 2], B0[2][FP8 ? 1 : 2], B1[2][FP8 ? 1 : 2];
    const char* cA = (const char*)g.A + (size_t)cur.arow * g.lda * 2; const char* cB = (const char*)g.Bt + (size_t)cur.brow * g.ldb * 2;
    const char* nA = cA;
    PG8_STAGE(PG8_SB(0, 0), cB, voffB); PG8_STAGE(PG8_SB(0, 1), cB + hstepB, voffB); PG8_STAGE_A(PG8_SA(0, 0), 0, 0, 0); PG8_STAGE_A(PG8_SA(0, 1), 1, 0, 0);
    if (wr == 1) PG8_BAR;
    PG8_WAIT_V(2); PG8_BAR;
    PG8_STAGE(PG8_SB(1, 0), cB + kstep, voffB); PG8_STAGE_A(PG8_SA(1, 0), 0, 0, kstep); PG8_STAGE(PG8_SB(1, 1), cB + hstepB + kstep, voffB);
    if constexpr (Epi::ST16 && !FP8 && !MIDK) PG8_WAIT_V(0); else PG8_WAIT_V(6);
    PG8_BAR;
    for (;;) {
        const bool has_next = S.next(ui + 1, nxt);
        nA = has_next ? (const char*)g.A + (size_t)nxt.arow * g.lda * 2 : cA; const char* nB = has_next ? (const char*)g.Bt + (size_t)nxt.brow * g.ldb * 2 : cB;
        const int nxu = has_next ? 1 : 0;
#define PG8_KPAIR(WV12) do { \
            if constexpr (MIDK) { if (t == (nt >> 1)) { const int le_ = lane_id(); E.mid(acc, cur, wr, wc, le_ & 15, le_ >> 4); } }        \
            const bool last = (t == nt - 2); \
            const size_t k1 = (size_t)(t + 1) * kstep, k2 = last ? 0 : (size_t)(t + 2) * kstep, k3 = k2 + kstep; const int nx2 = last ? nxu : 0; \
            const char* b2 = last ? nB : cB + (size_t)(t + 2) * kstep; const char* b3 = b2 + kstep; \
            PG8_LDB(B0, 0, 0); PG8_LDB(B1, 0, 1); PG8_SCHED; PG8_LDA(At, 0, 0); PG8_STAGE_A(PG8_SA(1, 1), 1, 0, k1); \
            WV12; PG8_WAIT_L(0); PG8_BAR; PG8_MMA(0, 0, At, B0); PG8_MMA(0, 1, At, B1); PG8_BAR; PG8_SCHED; \
            PG8_LDA(At, 0, 1); PG8_STAGE(PG8_SB(0, 0), b2, voffB); PG8_STAGE(PG8_SB(0, 1), b2 + hstepB, voffB); PG8_STAGE_A(PG8_SA(0, 0), 0, nx2, k2); \
            WV12; PG8_WAIT_L(0); PG8_BAR; PG8_MMA(1, 0, At, B0); PG8_MMA(1, 1, At, B1); PG8_BAR; PG8_SCHED; \
            PG8_LDB(B0, 1, 0); PG8_LDB(B1, 1, 1); PG8_SCHED; PG8_LDA(At, 1, 0); PG8_STAGE_A(PG8_SA(0, 1), 1, nx2, k2); \
            PG8_WAIT_V(8); PG8_WAIT_L(0); PG8_BAR; PG8_MMA(0, 0, At, B0); PG8_MMA(0, 1, At, B1); PG8_BAR; PG8_SCHED; \
            PG8_LDA(At, 1, 1); PG8_STAGE(PG8_SB(1, 0), b3, voffB); PG8_STAGE(PG8_SB(1, 1), b3 + hstepB, voffB); PG8_STAGE_A(PG8_SA(1, 0), 0, nx2, k3); \
            PG8_WAIT_V(8); PG8_WAIT_L(0); PG8_BAR; PG8_MMA(1, 0, At, B0); PG8_MMA(1, 1, At, B1); PG8_BAR; PG8_SCHED; } while (0)
        int t = 0;
        if constexpr (Epi::ST16 && !FP8 && !MIDK) { if (nt >= 4) { PG8_KPAIR(PG8_WAIT_V(24)); t = 2; } }
        for (; t < nt; t += 2) PG8_KPAIR(PG8_WAIT_V(8));
#undef PG8_KPAIR
        if (wr == 0) PG8_BAR;
        { const int le_ = lane_id(); E(acc, cur, wr, wc, le_ & 15, le_ >> 4); }
        if (!has_next) break;
#pragma unroll
        for (int a = 0; a < 2; ++a)
#pragma unroll
            for (int b = 0; b < 2; ++b)
#pragma unroll
                for (int m = 0; m < 4; ++m)
#pragma unroll
                    for (int n = 0; n < 2; ++n) acc[a][b][m][n] = (f32x4){0.f, 0.f, 0.f, 0.f};
        cur = nxt; cA = nA; cB = nB; ++ui;
        if (wr == 1) PG8_BAR;
    }
    PG8_WAIT_V(0);
    PG8_BAR;
#undef PG8_SA
#undef PG8_SB
#undef PG8_STAGE
#undef PG8_STAGE_A
#undef PG8_LDA
#undef PG8_LDB
#undef PG8_MMA
#undef PG8_WAIT_V
#undef PG8_WAIT_L
#undef PG8_BAR
#undef PG8_SCHED
}

#define EPI_LOOP_BEGIN \
    _Pragma("unroll") for (int ai = 0; ai < 2; ++ai) _Pragma("unroll") for (int m = 0; m < 4; ++m) { const int rloc = ai * HALF + wr * 64 + m * 16 + fr; \
    _Pragma("unroll") for (int bj = 0; bj < 2; ++bj) { const int cloc = wc * 64 + bj * 32 + 8 * fq; const f32x4 v0 = acc[ai][bj][m][0], v1 = acc[ai][bj][m][1];
#define EPI_LOOP_END } }

__device__ __forceinline__ unsigned epi_ror8(unsigned v) { return (unsigned)__builtin_amdgcn_update_dpp(0, (int)v, 0x128, 0xf, 0xf, true); }
__device__ __forceinline__ void epi_xch(bool lo, const u32x4& A, const u32x4& B, u32x4& d1, u32x4& d2) { const u32x4 snd = lo ? B : A; u32x4 rcv; rcv.x = epi_ror8(snd.x); rcv.y = epi_ror8(snd.y); rcv.z = epi_ror8(snd.z); rcv.w = epi_ror8(snd.w); d1 = lo ? A : rcv; d2 = lo ? rcv : B; }
__device__ __forceinline__ void epi_xch(bool lo, const u32x2& A, const u32x2& B, u32x2& d1, u32x2& d2) { const u32x2 snd = lo ? B : A; u32x2 rcv; rcv.x = epi_ror8(snd.x); rcv.y = epi_ror8(snd.y); d1 = lo ? A : rcv; d2 = lo ? rcv : B; }
__device__ __forceinline__ void epi_xch(bool lo, unsigned A, unsigned B, unsigned& d1, unsigned& d2) { const unsigned rcv = epi_ror8(lo ? B : A); d1 = lo ? A : rcv; d2 = lo ? rcv : B; }
#define EPI_BLK_BEGIN const bool lo_ = fr < 8; const int r7_ = fr & 7, cx_ = wc * 64 + 8 * fq + (lo_ ? 0 : 32); (void)r7_; (void)cx_; \
    _Pragma("unroll") for (int ai = 0; ai < 2; ++ai) _Pragma("unroll") for (int m = 0; m < 4; ++m) { const int rb_ = ai * HALF + wr * 64 + m * 16; (void)rb_;
#define EPI_BLK_END }

struct EpiStoreBf16 { static constexpr bool ST16 = true;
    bf16_t* O; int ld;
    __device__ __forceinline__ void operator()(const f32x4 (&acc)[2][2][4][2], const Unit& u, int wr, int wc, int fr, int fq) const {
        EPI_BLK_BEGIN
            u32x4 d1, d2; epi_xch(lo_, pack8(acc[ai][0][m][0], acc[ai][0][m][1]), pack8(acc[ai][1][m][0], acc[ai][1][m][1]), d1, d2);
            bf16_t* p = O + (size_t)(u.orow + rb_ + r7_) * ld + u.ocol + cx_; *(u32x4*)p = d1; *(u32x4*)(p + (size_t)8 * ld) = d2;
        EPI_BLK_END
    }
};
struct EpiStoreFp8 { static constexpr bool ST16 = true;
    unsigned char* O8;
    __device__ __forceinline__ void operator()(const f32x4 (&acc)[2][2][4][2], const Unit& u, int wr, int wc, int fr, int fq) const {
        EPI_BLK_BEGIN
            u32x2 a8, b8, d1, d2;
            a8.x = (unsigned)pack4_fp8(acc[ai][0][m][0][0], acc[ai][0][m][0][1], acc[ai][0][m][0][2], acc[ai][0][m][0][3]); a8.y = (unsigned)pack4_fp8(acc[ai][0][m][1][0], acc[ai][0][m][1][1], acc[ai][0][m][1][2], acc[ai][0][m][1][3]);
            b8.x = (unsigned)pack4_fp8(acc[ai][1][m][0][0], acc[ai][1][m][0][1], acc[ai][1][m][0][2], acc[ai][1][m][0][3]); b8.y = (unsigned)pack4_fp8(acc[ai][1][m][1][0], acc[ai][1][m][1][1], acc[ai][1][m][1][2], acc[ai][1][m][1][3]);
            epi_xch(lo_, a8, b8, d1, d2);
            unsigned char* p = O8 + (size_t)(u.orow + rb_ + r7_) * DM + u.ocol + cx_; *(u32x2*)p = d1; *(u32x2*)(p + (size_t)8 * DM) = d2;
        EPI_BLK_END
    }
};
struct EpiInProj8 { static constexpr bool ST16 = true;
    bf16_t* HM; unsigned char* ZG; bf16_t* Zp;
    __device__ __forceinline__ void operator()(const f32x4 (&acc)[2][2][4][2], const Unit& u, int wr, int wc, int fr, int fq) const {
        if (u.ocol >= NHM + ZGP) {
            EPI_LOOP_BEGIN
                const int zc = u.ocol - (NHM + ZGP) + cloc;
                if (zc < 24) *(u32x4*)(Zp + (size_t)(u.orow + rloc) * ZP + C_GN + zc) = pack8(v0, v1);
            EPI_LOOP_END
        } else if (u.ocol < NHM) {
            EPI_BLK_BEGIN
                u32x4 d1, d2; epi_xch(lo_, pack8(acc[ai][0][m][0], acc[ai][0][m][1]), pack8(acc[ai][1][m][0], acc[ai][1][m][1]), d1, d2);
                const int row = u.orow + rb_ + r7_, col = u.ocol + cx_;
                bf16_t* p = HM + ((size_t)((col >> 6) * BATCH + (row >> 11)) * SEQ + (row & (SEQ - 1))) * 64 + (col & 63); *(u32x4*)p = d1; *(u32x4*)(p + 8 * 64) = d2;
            EPI_BLK_END
        } else {
            EPI_BLK_BEGIN
                u32x2 a8, b8, d1, d2;
                a8.x = (unsigned)pack4_fp8(acc[ai][0][m][0][0], acc[ai][0][m][0][1], acc[ai][0][m][0][2], acc[ai][0][m][0][3]); a8.y = (unsigned)pack4_fp8(acc[ai][0][m][1][0], acc[ai][0][m][1][1], acc[ai][0][m][1][2], acc[ai][0][m][1][3]);
                b8.x = (unsigned)pack4_fp8(acc[ai][1][m][0][0], acc[ai][1][m][0][1], acc[ai][1][m][0][2], acc[ai][1][m][0][3]); b8.y = (unsigned)pack4_fp8(acc[ai][1][m][1][0], acc[ai][1][m][1][1], acc[ai][1][m][1][2], acc[ai][1][m][1][3]);
                epi_xch(lo_, a8, b8, d1, d2);
                unsigned char* p = ZG + zg_off(u.orow + rb_ + r7_, (u.ocol - NHM) + cx_); *(u32x2*)p = d1; *(u32x2*)(p + (size_t)(ZGP / 64) * 512) = d2;
            EPI_BLK_END
        }
    }
};
struct EpiInProjZ { static constexpr bool ST16 = false;
    bf16_t* Zp;
    __device__ __forceinline__ void operator()(const f32x4 (&acc)[2][2][4][2], const Unit& u, int wr, int wc, int fr, int fq) const {
        if (u.ocol < 512) {
            EPI_BLK_BEGIN
                u32x4 d1, d2; epi_xch(lo_, pack8(acc[ai][0][m][0], acc[ai][0][m][1]), pack8(acc[ai][1][m][0], acc[ai][1][m][1]), d1, d2);
                bf16_t* p = Zp + (size_t)(u.orow + rb_ + r7_) * ZP + C_CB + u.ocol + cx_; *(u32x4*)p = d1; *(u32x4*)(p + (size_t)8 * ZP) = d2;
            EPI_BLK_END
        } else if (u.ocol < 1536) {
            EPI_BLK_BEGIN
                u32x2 a, b, d1, d2;
                a.x = cvtpk(acc[ai][0][m][0][0] * acc[ai][0][m][0][1], acc[ai][0][m][0][2] * acc[ai][0][m][0][3]); a.y = cvtpk(acc[ai][0][m][1][0] * acc[ai][0][m][1][1], acc[ai][0][m][1][2] * acc[ai][0][m][1][3]);
                b.x = cvtpk(acc[ai][1][m][0][0] * acc[ai][1][m][0][1], acc[ai][1][m][0][2] * acc[ai][1][m][0][3]); b.y = cvtpk(acc[ai][1][m][1][0] * acc[ai][1][m][1][1], acc[ai][1][m][1][2] * acc[ai][1][m][1][3]);
                epi_xch(lo_, a, b, d1, d2);
                bf16_t* p = Zp + (size_t)(u.orow + rb_ + r7_) * ZP + C_U + ((u.ocol - 512 + cx_) >> 1); *(u32x2*)p = d1; *(u32x2*)(p + (size_t)8 * ZP) = d2;
            EPI_BLK_END
        } else {
            EPI_LOOP_BEGIN
                const int zc = u.ocol - 1536 + cloc;
                if (zc < 24) *(u32x4*)(Zp + (size_t)(u.orow + rloc) * ZP + C_GN + zc) = pack8(v0, v1);
            EPI_LOOP_END
        }
    }
};
struct EpiMerge { static constexpr bool ST16 = true;
    bf16_t* T; const unsigned char* ZG; mutable u32x2 gkeep[16];
    __device__ __forceinline__ void mid(f32x4 (&acc)[2][2][4][2], const Unit& u, int wr, int wc, int fr, int fq) const {
        asm volatile("" : "+v"(fr), "+v"(fq));
        u32x2 gn_[16], gc_[16];
        { EPI_BLK_BEGIN
            const unsigned char* pn = ZG + zg_off(u.orow + rb_ + r7_, C_GMN + u.ocol + cx_); const unsigned char* pc = ZG + zg_off(u.orow + rb_ + r7_, C_GMC + u.ocol + cx_);
            gn_[(ai * 4 + m) * 2] = *(const u32x2*)pn; gn_[(ai * 4 + m) * 2 + 1] = *(const u32x2*)(pn + (size_t)(ZGP / 64) * 512);
            gc_[(ai * 4 + m) * 2] = *(const u32x2*)pc; gc_[(ai * 4 + m) * 2 + 1] = *(const u32x2*)(pc + (size_t)(ZGP / 64) * 512);
          EPI_BLK_END }
        asm volatile("" ::: "memory");
#pragma unroll
        for (int i = 0; i < 16; ++i) gkeep[i] = gc_[i];
        { EPI_BLK_BEGIN
            u32x2 gnv[2], gcv[2]; epi_xch(lo_, gn_[(ai * 4 + m) * 2], gn_[(ai * 4 + m) * 2 + 1], gnv[0], gnv[1]); epi_xch(lo_, gc_[(ai * 4 + m) * 2], gc_[(ai * 4 + m) * 2 + 1], gcv[0], gcv[1]);
#pragma unroll
            for (int bj = 0; bj < 2; ++bj) { f32x4 n0, n1, c0, c1; unpack8_fp8(gnv[bj], n0, n1); unpack8_fp8(gcv[bj], c0, c1);
#pragma unroll
                for (int e = 0; e < 4; ++e) { acc[ai][bj][m][0][e] *= (1.f + __expf(-c0[e])) * __builtin_amdgcn_rcpf(1.f + __expf(-n0[e])); acc[ai][bj][m][1][e] *= (1.f + __expf(-c1[e])) * __builtin_amdgcn_rcpf(1.f + __expf(-n1[e])); } }
          EPI_BLK_END }
    }
    __device__ __forceinline__ void operator()(const f32x4 (&acc)[2][2][4][2], const Unit& u, int wr, int wc, int fr, int fq) const {
        u32x2 gt[16];
#pragma unroll
        for (int i = 0; i < 16; ++i) gt[i] = gkeep[i];
        EPI_BLK_BEGIN
            u32x2 gv[2]; epi_xch(lo_, gt[(ai * 4 + m) * 2], gt[(ai * 4 + m) * 2 + 1], gv[0], gv[1]);
            u32x4 pk[2];
#pragma unroll
            for (int bj = 0; bj < 2; ++bj) { f32x4 g0, g1; unpack8_fp8(gv[bj], g0, g1); f32x4 o0, o1;
#pragma unroll
                for (int e = 0; e < 4; ++e) { o0[e] = sigm(g0[e]) * acc[ai][bj][m][0][e]; o1[e] = sigm(g1[e]) * acc[ai][bj][m][1][e]; }
                pk[bj] = pack8(o0, o1); }
            u32x4 d1, d2; epi_xch(lo_, pk[0], pk[1], d1, d2);
            bf16_t* p = T + (size_t)(u.orow + rb_ + r7_) * DM + u.ocol + cx_; *(u32x4*)p = d1; *(u32x4*)(p + (size_t)8 * DM) = d2;
        EPI_BLK_END
    }
};
struct EpiResBf16 { static constexpr bool ST16 = true;
    bf16_t* H; const bf16_t* X;
    __device__ __forceinline__ void operator()(const f32x4 (&acc)[2][2][4][2], const Unit& u, int wr, int wc, int fr, int fq) const {
        u32x4 xin[16];
        EPI_LOOP_BEGIN
            xin[(ai * 4 + m) * 2 + bj] = *(const u32x4*)(X + (size_t)(u.orow + rloc) * DM + u.ocol + cloc); (void)v0; (void)v1;
        EPI_LOOP_END
        asm volatile("" ::: "memory");
        EPI_BLK_BEGIN
            u32x4 pk[2];
#pragma unroll
            for (int bj = 0; bj < 2; ++bj) { f32x4 x0, x1; unpack8(xin[(ai * 4 + m) * 2 + bj], x0, x1); pk[bj] = pack8(x0 * ALPHA + acc[ai][bj][m][0], x1 * ALPHA + acc[ai][bj][m][1]); }
            u32x4 d1, d2; epi_xch(lo_, pk[0], pk[1], d1, d2);
            bf16_t* p = H + (size_t)(u.orow + rb_ + r7_) * DM + u.ocol + cx_; *(u32x4*)p = d1; *(u32x4*)(p + (size_t)8 * DM) = d2;
        EPI_BLK_END
    }
};
struct EpiPle { static constexpr bool ST16 = true;
    bf16_t* P; const float* bias; const bf16_t* X1; const unsigned char* T8; const float* stat; const float* lng; const float* lnb;
    __device__ __forceinline__ void operator()(const f32x4 (&acc)[2][2][4][2], const Unit& u, int wr, int wc, int fr, int fq) const {
        f32x4 bs[2][2], gs[2][2], bb[2][2];
#pragma unroll
        for (int bj = 0; bj < 2; ++bj) { const int col = u.ocol + wc * 64 + bj * 32 + 8 * fq; bs[bj][0] = *(const f32x4*)(bias + col); bs[bj][1] = *(const f32x4*)(bias + col + 4);
            gs[bj][0] = *(const f32x4*)(lng + col) * ALPHA; gs[bj][1] = *(const f32x4*)(lng + col + 4) * ALPHA; bb[bj][0] = *(const f32x4*)(lnb + col) * ALPHA; bb[bj][1] = *(const f32x4*)(lnb + col + 4) * ALPHA; }
        const bool lo_ = fr < 8; const int r7_ = fr & 7, cx_ = wc * 64 + 8 * fq + (lo_ ? 0 : 32);
#pragma unroll
        for (int ai = 0; ai < 2; ++ai) {
            u32x2 tin[8]; u32x4 xin[8]; f32x2 st[4];
#pragma unroll
            for (int m = 0; m < 4; ++m) { st[m] = *(const f32x2*)(stat + 2 * (size_t)(u.orow + ai * HALF + wr * 64 + m * 16 + fr));
#pragma unroll
                for (int bj = 0; bj < 2; ++bj) { const size_t off = (size_t)(u.orow + ai * HALF + wr * 64 + m * 16 + fr) * DM + u.ocol + wc * 64 + bj * 32 + 8 * fq;
                    tin[m * 2 + bj] = *(const u32x2*)(T8 + off); xin[m * 2 + bj] = *(const u32x4*)(X1 + off); } }
            asm volatile("" ::: "memory");
#pragma unroll
            for (int m = 0; m < 4; ++m) { u32x4 pk[2]; const float ra = st[m][1], rc = -st[m][0] * st[m][1];
#pragma unroll
                for (int bj = 0; bj < 2; ++bj) { const f32x4 v0 = acc[ai][bj][m][0], v1 = acc[ai][bj][m][1];
                    f32x4 t0, t1, x0, x1_; unpack8_fp8(tin[m * 2 + bj], t0, t1); unpack8(xin[m * 2 + bj], x0, x1_); f32x4 o0, o1;
#pragma unroll
                    for (int e = 0; e < 4; ++e) { o0[e] = ((x0[e] * ra + rc) * gs[bj][0][e] + bb[bj][0][e]) + sigm(v0[e] + bs[bj][0][e]) * t0[e]; o1[e] = ((x1_[e] * ra + rc) * gs[bj][1][e] + bb[bj][1][e]) + sigm(v1[e] + bs[bj][1][e]) * t1[e]; }
                    pk[bj] = pack8(o0, o1); }
                u32x4 d1, d2; epi_xch(lo_, pk[0], pk[1], d1, d2);
                bf16_t* p = P + (size_t)(u.orow + ai * HALF + wr * 64 + m * 16 + r7_) * DM + u.ocol + cx_; *(u32x4*)p = d1; *(u32x4*)(p + (size_t)8 * DM) = d2; }
            asm volatile("" ::: "memory");
        }
    }
};
struct EpiSwiGlu { static constexpr bool ST16 = false;
    unsigned char* HS8; const LAS float* WT;
    __device__ __forceinline__ void operator()(const f32x4 (&acc)[2][2][4][2], const Unit& u, int wr, int wc, int fr, int fq) const {
        const LAS float* wt_ = WT + u.idx * 256 + wr * 64 + fr;
        EPI_BLK_BEGIN
            unsigned hk[2]; const float w_ = wt_[ai * HALF + m * 16];
#pragma unroll
            for (int bj = 0; bj < 2; ++bj) { const f32x4 v0 = acc[ai][bj][m][0], v1 = acc[ai][bj][m][1];
                const float h0 = v0[0] * sigm(v0[0]) * v0[1], h1 = v0[2] * sigm(v0[2]) * v0[3], h2 = v1[0] * sigm(v1[0]) * v1[1], h3 = v1[2] * sigm(v1[2]) * v1[3];
                hk[bj] = (unsigned)pack4_fp8(h0 * w_, h1 * w_, h2 * w_, h3 * w_); }
            unsigned d1, d2; epi_xch(lo_, hk[0], hk[1], d1, d2);
            const int r1 = rb_ + r7_; unsigned char* p = HS8 + (size_t)(u.orow + r1) * EH + ((u.ocol + cx_) >> 1);
            if (r1 < u.nvalid) *(unsigned*)p = d1;
            if (r1 + 8 < u.nvalid) *(unsigned*)(p + (size_t)8 * EH) = d2;
        EPI_BLK_END
    }
};
struct EpiScaleRows { static constexpr bool ST16 = false;
    unsigned char* YS8;
    __device__ __forceinline__ void operator()(const f32x4 (&acc)[2][2][4][2], const Unit& u, int wr, int wc, int fr, int fq) const {
        EPI_BLK_BEGIN
            constexpr float w = 1.f; u32x2 a8, b8, d1, d2;
            a8.x = (unsigned)pack4_fp8(acc[ai][0][m][0][0] * w, acc[ai][0][m][0][1] * w, acc[ai][0][m][0][2] * w, acc[ai][0][m][0][3] * w); a8.y = (unsigned)pack4_fp8(acc[ai][0][m][1][0] * w, acc[ai][0][m][1][1] * w, acc[ai][0][m][1][2] * w, acc[ai][0][m][1][3] * w);
            b8.x = (unsigned)pack4_fp8(acc[ai][1][m][0][0] * w, acc[ai][1][m][0][1] * w, acc[ai][1][m][0][2] * w, acc[ai][1][m][0][3] * w); b8.y = (unsigned)pack4_fp8(acc[ai][1][m][1][0] * w, acc[ai][1][m][1][1] * w, acc[ai][1][m][1][2] * w, acc[ai][1][m][1][3] * w);
            epi_xch(lo_, a8, b8, d1, d2);
            const int r1 = rb_ + r7_; unsigned char* p = YS8 + (size_t)(u.orow + r1) * DM + u.ocol + cx_;
            if (r1 < u.nvalid) *(u32x2*)p = d1;
            if (r1 + 8 < u.nvalid) *(u32x2*)(p + (size_t)8 * DM) = d2;
        EPI_BLK_END
    }
};
}

#define XB_TMO      128
#define XB_XCNT(j)  (256  + 64 * (j))
#define XB_XSUB(j)  (1280 + 64 * (j))
#define XB_XGEN(j)  (2304 + 64 * (j))
#define XB_TOP      3328
#define XB_TOPGEN   3392
#define XCD_BAR_WORDS 3456
#define XB_SPIN_CAP (1u << 18)
__device__ __forceinline__ unsigned xb_ld(unsigned* p)              { return __hip_atomic_load(p, __ATOMIC_RELAXED, __HIP_MEMORY_SCOPE_AGENT); }
__device__ __forceinline__ unsigned xb_add(unsigned* p, unsigned v) { return __hip_atomic_fetch_add(p, v, __ATOMIC_RELAXED, __HIP_MEMORY_SCOPE_AGENT); }
__device__ __forceinline__ unsigned xb_xcc_id() { return (unsigned)__builtin_amdgcn_s_getreg((3 << 11) | 20) & 0xFu; }
#define XB_SPIN(cond, bar) do { unsigned _sp = 0; while (cond) { __builtin_amdgcn_s_sleep(1); \
    if ((++_sp & 255u) == 0u) { if (xb_ld(&(bar)[XB_TMO])) break; if (_sp > XB_SPIN_CAP) { atomicAdd(&(bar)[XB_TMO], 1u); break; } } } } while (0)
struct XcdBarrier { unsigned* bar; unsigned x; volatile LAS unsigned* st; };
__device__ __forceinline__ XcdBarrier xcd_barrier_post(unsigned* bar, volatile LAS unsigned* st) {
    XcdBarrier b; b.bar = bar; b.x = xb_xcc_id(); b.st = st;
    if (threadIdx.x == 0) (void)xb_add(&bar[XB_XCNT(b.x)], 1u);
    return b;
}
__device__ __forceinline__ void xcd_barrier_complete(unsigned* bar, unsigned x, unsigned& nloc, unsigned& nx) {
    const unsigned G = gridDim.x * gridDim.y * gridDim.z;
    unsigned sum, cnt, mine, sp = 0u;
    for (;;) {
        sum = 0u; cnt = 0u; mine = 0u;
#pragma unroll
        for (unsigned j = 0; j < 16; ++j) { const unsigned c = xb_ld(&bar[XB_XCNT(j)]); sum += c; cnt += (c > 0u) ? 1u : 0u; mine = (j == x) ? c : mine; }
        if (sum == G) break;
        __builtin_amdgcn_s_sleep(1);
        if ((++sp & 255u) == 0u) { if (xb_ld(&bar[XB_TMO])) break; if (sp > XB_SPIN_CAP) { atomicAdd(&bar[XB_TMO], 1u); break; } }
    }
    nloc = mine > 0u ? mine : 1u; nx = cnt > 0u ? cnt : 1u;
}
__device__ __forceinline__ void xcd_barrier(const XcdBarrier& b) {
    asm volatile("s_waitcnt vmcnt(0)" ::: "memory");
    __syncthreads();
    if (threadIdx.x == 0) {
        unsigned* bar = b.bar;
        __builtin_amdgcn_s_waitcnt(0);
        unsigned nloc = b.st[0], nx = b.st[1];
        if (nloc == 0u) { xcd_barrier_complete(bar, b.x, nloc, nx); b.st[0] = nloc; b.st[1] = nx; }
        const unsigned old = xb_add(&bar[XB_XSUB(b.x)], 1u);
        const unsigned gen = old / nloc;
        if (old + 1u == (gen + 1u) * nloc) {
            __builtin_amdgcn_fence(__ATOMIC_RELEASE, "agent");
            asm volatile("s_waitcnt vmcnt(0)" ::: "memory");
            const unsigned og = xb_add(&bar[XB_TOP], 1u);
            const unsigned tg = og / nx;
            if (og + 1u == (tg + 1u) * nx) xb_add(&bar[XB_TOPGEN], 1u);
            else XB_SPIN(xb_ld(&bar[XB_TOPGEN]) == tg, bar);
            __builtin_amdgcn_fence(__ATOMIC_ACQUIRE, "agent");
            xb_add(&bar[XB_XGEN(b.x)], 1u);
            asm volatile("s_waitcnt vmcnt(0)" ::: "memory");
        } else {
            XB_SPIN(xb_ld(&bar[XB_XGEN(b.x)]) == gen, bar);
            __builtin_amdgcn_fence(__ATOMIC_ACQUIRE, "agent");
            asm volatile("s_waitcnt vmcnt(0)" ::: "memory");
        }
    }
    __syncthreads();
}


namespace att {
typedef float f32x16 __attribute__((ext_vector_type(16)));
typedef short s16x4 __attribute__((ext_vector_type(4)));
constexpr int L_K = 0, L_V = 32768, L_WSF = 65536, L_IMPG = 67584, L_OST = L_IMPG, L_IMPL = L_IMPG + 33792, L_SC = L_IMPL + 33792, L_SELM = L_SC + 64 * 36 * 4, L_UNI = L_SELM + 256, L_END = L_UNI + 16;
static_assert(L_END <= LDS_BYTES - RING_OFF, "attention LDS map");
constexpr float NEG = -2e30f, MINIT = -1e30f;
#define MFMA32(a, b, c) __builtin_amdgcn_mfma_f32_32x32x16_bf16((a), (b), (c), 0, 0, 0)
__device__ __forceinline__ int crow(int r, int hi) { return (r & 3) + 8 * (r >> 2) + 4 * hi; }
__device__ __forceinline__ void glds16s(const void* sbase_, unsigned voff, unsigned lds_dst) { unsigned keep;
    const unsigned long long sb_ = (unsigned long long)sbase_;
    const unsigned long long sbase = ((unsigned long long)(unsigned)__builtin_amdgcn_readfirstlane((int)(sb_ >> 32)) << 32) | (unsigned)__builtin_amdgcn_readfirstlane((int)sb_);
    asm volatile("s_mov_b32 %0, m0\n\ts_mov_b32 m0, %3\n\ts_nop 0\n\tglobal_load_lds_dwordx4 %1, %2\n\ts_mov_b32 m0, %0" : "=&s"(keep) : "v"(voff), "s"(sbase), "s"(lds_dst) : "memory"); }
__device__ __forceinline__ int kswz(int r) { return (r & 7) ^ ((r >> 3) & 1); }
__device__ __forceinline__ unsigned kdma_off(int wid, int lane) { const int r = 8 * wid + (lane >> 3); return (unsigned)(r * 128 + (((lane & 7) ^ kswz(r)) << 4)); }
__device__ __forceinline__ unsigned vdma_off(int wid, int lane) { return (unsigned)((8 * wid + (lane >> 3)) * 128 + ((((lane & 7) >> 1) ^ ((lane >> 3) & 2)) << 5) + ((lane & 1) << 4)); }
__device__ __forceinline__ int kfrag_off(int r32, int hi) { return r32 * 128 + ((hi ^ kswz(r32)) << 4); }
__device__ __forceinline__ void dma_kv(const bf16_t* Kb, const bf16_t* Vb, int tile, unsigned kdst, unsigned vdst, int wid, int lane) {
    glds16s(Kb + (size_t)tile * 4096, kdma_off(wid, lane), kdst + (unsigned)wid * 1024u);
    glds16s(Vb + (size_t)tile * 4096, vdma_off(wid, lane), vdst + (unsigned)wid * 1024u);
}
__device__ __forceinline__ void branch_prologue(const bf16_t* Kb, const bf16_t* Vb, int qt, int t1, unsigned lds0, int wid, int lane) {
    glds16s(Kb + (size_t)qt * 4096, kdma_off(wid, lane), lds0 + L_K + (unsigned)wid * 1024u);
    if (t1 >= 0) glds16s(Kb + (size_t)t1 * 4096, kdma_off(wid, lane), lds0 + L_K + 8192u + (unsigned)wid * 1024u);
    glds16s(Vb + (size_t)qt * 4096, vdma_off(wid, lane), lds0 + L_V + (unsigned)wid * 1024u);
}
__device__ __forceinline__ void qkt(f32x16& p0, f32x16& p1, const LAS unsigned char* Kslot, const bf16x8* qr, int r32, int hi) {
    const unsigned kb = (unsigned)(size_t)Kslot + (unsigned)kfrag_off(r32, hi);
    f32x16 z; for (int i = 0; i < 16; ++i) z[i] = 0.f;
    p0 = z; p1 = z;
#pragma unroll
    for (int d0 = 0; d0 < 4; ++d0) { const LAS unsigned char* kd = (const LAS unsigned char*)(size_t)(kb ^ (unsigned)(d0 << 5)); const bf16x8 b0 = *(const LAS bf16x8*)(kd), b1 = *(const LAS bf16x8*)(kd + 4096);
        p0 = MFMA32(b0, qr[d0], p0); p1 = MFMA32(b1, qr[d0], p1); }
}
__device__ __forceinline__ void pv(f32x16* o, unsigned vb, bf16x8 pa0, bf16x8 pa1, bf16x8 pa2, bf16x8 pa3) {
#pragma unroll
    for (int d0 = 0; d0 < 2; ++d0) { s16x4 lo[4], hi[4];
#pragma unroll
        for (int ks = 0; ks < 4; ++ks) {
            asm volatile("ds_read_b64_tr_b16 %0,%1 offset:%c2" : "=&v"(lo[ks]) : "v"(vb ^ (unsigned)(d0 << 6)), "i"(ks * 2048) : "memory");
            asm volatile("ds_read_b64_tr_b16 %0,%1 offset:%c2" : "=&v"(hi[ks]) : "v"(vb ^ (unsigned)(d0 << 6)), "i"(ks * 2048 + 1024) : "memory"); }
        asm volatile("s_waitcnt lgkmcnt(0)" ::: "memory"); __builtin_amdgcn_sched_barrier(0);
#define PK(k) (bf16x8){lo[k][0], lo[k][1], lo[k][2], lo[k][3], hi[k][0], hi[k][1], hi[k][2], hi[k][3]}
        o[d0] = MFMA32(pa0, PK(0), o[d0]); o[d0] = MFMA32(pa1, PK(1), o[d0]); o[d0] = MFMA32(pa2, PK(2), o[d0]); o[d0] = MFMA32(pa3, PK(3), o[d0]);
#undef PK
    }
}
__device__ __forceinline__ float half_swap_max(float m) { auto rr = __builtin_amdgcn_permlane32_swap(__float_as_uint(m), __float_as_uint(m), false, false); return __builtin_fmaxf(__uint_as_float(rr[0]), __uint_as_float(rr[1])); }
__device__ __forceinline__ float half_swap_sum(float m) { auto rr = __builtin_amdgcn_permlane32_swap(__float_as_uint(m), __float_as_uint(m), false, false); return __uint_as_float(rr[0]) + __uint_as_float(rr[1]); }
__device__ __forceinline__ float rowmax32(const f32x16& p0, const f32x16& p1) { float a = __builtin_fmaxf(p0[0], p1[0]);
#pragma unroll
    for (int r = 1; r < 16; ++r) a = __builtin_fmaxf(a, __builtin_fmaxf(p0[r], p1[r]));
    return half_swap_max(a); }
__device__ __forceinline__ bf16x8 packp(const f32x16& p, int b) { u32x4 w; w.x = cvtpk(p[b], p[b + 1]); w.y = cvtpk(p[b + 2], p[b + 3]); w.z = cvtpk(p[b + 4], p[b + 5]); w.w = cvtpk(p[b + 6], p[b + 7]); return __builtin_bit_cast(bf16x8, w); }
__device__ __forceinline__ float max3f(float a, float b, float c) { return __builtin_fmaxf(__builtin_fmaxf(a, b), c); }
constexpr float THR = 8.f;
__device__ __forceinline__ void mask_tile(f32x16& p0, f32x16& p1, int mode, bool, int ql, int hi) {
    const int x = ql - 4 * hi;
    if (mode == 1) {
#pragma unroll
        for (int r = 0; r < 16; ++r) { const int cr = (r & 3) + 8 * (r >> 2); p0[r] = (x < cr) ? NEG : p0[r]; p1[r] = (x < cr + 32) ? NEG : p1[r]; }
    } else {
#pragma unroll
        for (int r = 0; r < 16; ++r) { const int cr = (r & 3) + 8 * (r >> 2); p0[r] = (x >= cr) ? NEG : p0[r]; p1[r] = (x >= cr + 32) ? NEG : p1[r]; }
    }
}
__device__ __forceinline__ float max32(const f32x16& p0, const f32x16& p1) {
    float a = max3f(p0[0], p0[1], p1[0]), b = max3f(p0[2], p0[3], p1[1]); a = max3f(a, p1[2], p1[3]);
#pragma unroll
    for (int r = 4; r < 16; r += 4) { a = max3f(a, p0[r], p0[r + 1]); b = max3f(b, p0[r + 2], p0[r + 3]); a = max3f(a, p1[r], p1[r + 1]); b = max3f(b, p1[r + 2], p1[r + 3]); }
    return __builtin_fmaxf(a, b);
}
typedef __attribute__((address_space(3))) const unsigned char* lds_cptr;
typedef short v4i16_t __attribute__((ext_vector_type(4)));
__device__ __forceinline__ s16x4 vtr(lds_cptr p) { return __builtin_bit_cast(s16x4, __builtin_amdgcn_ds_read_tr16_b64_v4i16((__attribute__((address_space(3))) v4i16_t*)p)); }
__device__ __forceinline__ void kload8(bf16x8* kf, lds_cptr kp) {
    const unsigned k0 = (unsigned)(size_t)kp;
#pragma unroll
    for (int d0 = 0; d0 < 4; ++d0) { lds_cptr kd = (lds_cptr)(size_t)(k0 ^ (unsigned)(d0 << 5)); kf[2 * d0] = *(const LAS bf16x8*)(kd); kf[2 * d0 + 1] = *(const LAS bf16x8*)(kd + 4096); } }

template <bool SEL, bool PRE = false, bool NEXT = false>
__device__ __forceinline__ void run_branch_pipe(f32x16* o, float& l_out, unsigned tiles, unsigned selm, int qt, int jw, const bf16_t* Kb, const bf16_t* Vb, LAS unsigned char* ring, unsigned lds0,
                                                const bf16x8* qr, int r32, int hi, int ql, int wid, int lane, unsigned vtr_off, LAS float* wsf,
                                                int& rot) {
    constexpr size_t NXT = (size_t)(HS_KW - HS_KS) * BATCH * SEQ * 64;
#define P_SBAR() __builtin_amdgcn_sched_barrier(0)
#define P_PIN(x) asm volatile("" : "+v"(x))
#define P_WB(n) asm volatile("s_waitcnt vmcnt(" #n ") lgkmcnt(0)\n\ts_barrier" ::: "memory")
#define P_WBN(n_) do { const int nn_ = (n_); if (nn_ <= 0) P_WB(0); else if (nn_ == 1) P_WB(1); else P_WB(2); } while (0)
#define P_PKW(P, B) (SEL ? (cvtpk(P[B], P[B + 1]) & onm_prev) : cvtpk(P[B], P[B + 1]))
#define P_PAF(k) __builtin_bit_cast(bf16x8, pw##k)
#define P_VFR(i) (bf16x8){vlo[i][0], vlo[i][1], vlo[i][2], vlo[i][3], vhi[i][0], vhi[i][1], vhi[i][2], vhi[i][3]}
#define P_GAPA(MF, A0, A1, A2, A3, W0, W1, PW) do { MF; sacc += A0; sacc += A1; sacc += A2; sacc += A3; P_PIN(sacc); W0; W1; P_PIN(PW); P_SBAR(); } while (0)
#define P_EX(v) __builtin_amdgcn_exp2f(v)
#define P_GAPB(MF, X, B) do { MF; X[B] = P_EX(X[B]); X[B + 1] = P_EX(X[B + 1]); X[B + 2] = P_EX(X[B + 2]); X[B + 3] = P_EX(X[B + 3]); P_PIN(X); P_SBAR(); } while (0)
#define P_VRD(i) do { vlo[i] = vtr((((i) >> 2) ? vp1_ : vp_) + ((i) & 3) * 2048); vhi[i] = vtr((((i) >> 2) ? vp1_ : vp_) + ((i) & 3) * 2048 + 1024); } while (0)
#define P_DMAK(t_, slot_) glds16s(Kb + (size_t)(t_) * 4096, kdma_off(wid, lane), lds0 + L_K + (unsigned)(slot_) * 8192u + (unsigned)wid * 1024u)
#define P_DMAV(t_, slot_) glds16s(Vb + (size_t)(t_) * 4096, vdma_off(wid, lane), lds0 + L_V + (unsigned)(slot_) * 8192u + (unsigned)wid * 1024u)
#define P_ISSUE() do { n_last = 0; if (tq2 >= 0) { P_DMAK(tq2, s2); ++n_last; } if (tq1 >= 0) { P_DMAV(tq1, s1); ++n_last; } } while (0)
#define P_SHIFT() do { tq0 = tq1; tq1 = tq2; tq2 = -1; if (rem) { tq2 = __builtin_ctz(rem); rem &= rem - 1u; } const int s_ = s0; s0 = s1; s1 = s2; s2 = s_; } while (0)
#define P_RESC() do { if (resc) { LDS_WAIT(); _Pragma("unroll") for (int r = 0; r < 16; ++r) { const float f_ = wsf[crow(r, hi)]; o[0][r] *= f_; o[1][r] *= f_; } } } while (0)
#define P_STEP(C0, C1, P0, P1) do { P_SBAR(); \
    const unsigned onm_cur = SEL ? (0u - ((selm >> tq0) & 1u)) : 0xffffffffu; \
    kload8(kf, (lds_cptr)(ring + L_K + s0 * 8192) + kfrag_off(r32, hi)); \
    const lds_cptr vp_ = (lds_cptr)(ring + L_V + s2 * 8192) + vtr_off; const lds_cptr vp1_ = (lds_cptr)(size_t)((unsigned)(size_t)vp_ ^ 64u); \
    float sacc = (P0[0] + P0[1]); \
    P_GAPA(C0 = MFMA32(kf[0], qr[0], negm), P0[2], P0[3], P0[4], P0[5],     pw0[0] = P_PKW(P0, 0), pw0[1] = P_PKW(P0, 2), pw0); \
    P_GAPA(C1 = MFMA32(kf[1], qr[0], negm), P0[6], P0[7], P0[8], P0[9],     pw0[2] = P_PKW(P0, 4), pw0[3] = P_PKW(P0, 6), pw0); \
    P_GAPA(C0 = MFMA32(kf[2], qr[1], C0),   P0[10], P0[11], P0[12], P0[13], pw1[0] = P_PKW(P0, 8), pw1[1] = P_PKW(P0, 10), pw1); \
    P_GAPA(C1 = MFMA32(kf[3], qr[1], C1),   P0[14], P0[15], P1[0], P1[1],   pw1[2] = P_PKW(P0, 12), pw1[3] = P_PKW(P0, 14), pw1); \
    P_GAPA(C0 = MFMA32(kf[4], qr[2], C0),   P1[2], P1[3], P1[4], P1[5],     pw2[0] = P_PKW(P1, 0), pw2[1] = P_PKW(P1, 2), pw2); \
    P_GAPA(C1 = MFMA32(kf[5], qr[2], C1),   P1[6], P1[7], P1[8], P1[9],     pw2[2] = P_PKW(P1, 4), pw2[3] = P_PKW(P1, 6), pw2); \
    P_GAPA(C0 = MFMA32(kf[6], qr[3], C0),   P1[10], P1[11], P1[12], P1[13], pw3[0] = P_PKW(P1, 8), pw3[1] = P_PKW(P1, 10), pw3); \
    P_GAPA(C1 = MFMA32(kf[7], qr[3], C1),   P1[14], P1[15], 0.f, 0.f,       pw3[2] = P_PKW(P1, 12), pw3[3] = P_PKW(P1, 14), pw3); \
    l_reg += SEL ? __uint_as_float(__float_as_uint(sacc) & onm_prev) : sacc; onm_prev = onm_cur; \
    P_VRD(0); P_VRD(4); \
    if (!SEL) { if (tq0 == jw) { asm volatile("" ::: "memory"); mask_tile(C0, C1, 2, true, ql, hi); } }     \
    { float rm = half_swap_max(max32(C0, C1)); resc = false; \
      if (__builtin_expect(__any(rm > THR), 0)) { const float dl = __builtin_fmaxf(rm, 0.f); mref += dl; \
          _Pragma("unroll") for (int r = 0; r < 16; ++r) { C0[r] -= dl; C1[r] -= dl; } \
          _Pragma("unroll") for (int r = 0; r < 16; ++r) negm[r] = -mref; asm volatile("" : "+v"(negm)); \
          const float f = __builtin_amdgcn_exp2f(-dl); l_reg *= f; if (hi == 0) wsf[r32] = f; resc = true; } } \
    P_SBAR(); \
    P_VRD(1); P_GAPB(o[0] = MFMA32(P_PAF(0), P_VFR(0), o[0]), C0, 0); \
    P_VRD(5); P_GAPB(o[1] = MFMA32(P_PAF(0), P_VFR(4), o[1]), C0, 4); \
    P_VRD(2); P_GAPB(o[0] = MFMA32(P_PAF(1), P_VFR(1), o[0]), C0, 8); \
    P_VRD(6); P_GAPB(o[1] = MFMA32(P_PAF(1), P_VFR(5), o[1]), C0, 12); \
    P_VRD(3); P_GAPB(o[0] = MFMA32(P_PAF(2), P_VFR(2), o[0]), C1, 0); \
    P_VRD(7); P_GAPB(o[1] = MFMA32(P_PAF(2), P_VFR(6), o[1]), C1, 4); \
    P_GAPB(o[0] = MFMA32(P_PAF(3), P_VFR(3), o[0]), C1, 8); \
    P_GAPB(o[1] = MFMA32(P_PAF(3), P_VFR(7), o[1]), C1, 12); \
    } while (0)
#define P_DRAIN(PB0, PB1) do { P_WB(0); \
      if constexpr (NEXT) { glds16s(Kb + NXT + (size_t)qt * 4096, kdma_off(wid, lane), lds0 + L_K + (unsigned)s0 * 8192u + (unsigned)wid * 1024u); \
          if (qt > 0) glds16s(Kb + NXT + (size_t)(qt >= 8 ? qt - 8 : 0) * 4096, kdma_off(wid, lane), lds0 + L_K + (unsigned)s1 * 8192u + (unsigned)wid * 1024u); \
          glds16s(Vb + NXT + (size_t)qt * 4096, vdma_off(wid, lane), lds0 + L_V + (unsigned)s0 * 8192u + (unsigned)wid * 1024u); rot = s0; } \
      float sacc = 0.f; \
      _Pragma("unroll") for (int r = 0; r < 16; ++r) sacc += PB0[r] + PB1[r]; \
      l_reg += SEL ? __uint_as_float(__float_as_uint(sacc) & onm_prev) : sacc; \
      u32x4 d0_ = __builtin_bit_cast(u32x4, packp(PB0, 0)), d1_ = __builtin_bit_cast(u32x4, packp(PB0, 8)), d2_ = __builtin_bit_cast(u32x4, packp(PB1, 0)), d3_ = __builtin_bit_cast(u32x4, packp(PB1, 8)); \
      if (SEL) { d0_ &= onm_prev; d1_ &= onm_prev; d2_ &= onm_prev; d3_ &= onm_prev; } \
      pv(o, lds0 + L_V + (unsigned)s2 * 8192u + vtr_off, __builtin_bit_cast(bf16x8, d0_), __builtin_bit_cast(bf16x8, d1_), __builtin_bit_cast(bf16x8, d2_), __builtin_bit_cast(bf16x8, d3_)); } while (0)
#define P_BODY(C0, C1, P0, P1) do { P_WBN(n_last); P_ISSUE(); P_STEP(C0, C1, P0, P1); P_RESC(); P_SHIFT(); } while (0)
    unsigned rem = tiles & ~(1u << qt);
    int tq0 = qt, tq1 = -1, tq2 = -1, s0 = PRE ? rot : 0, s1 = s0 == 2 ? 0 : s0 + 1, s2 = s1 == 2 ? 0 : s1 + 1, n_last;
    if (rem) { tq1 = __builtin_ctz(rem); rem &= rem - 1u; }
    if (rem) { tq2 = __builtin_ctz(rem); rem &= rem - 1u; }
    if constexpr (!PRE) {
    P_DMAK(tq0, 0);
    if (tq1 >= 0) P_DMAK(tq1, 1);
    P_DMAV(tq0, 0);
    }
    float mref = 0.f, l_reg = 0.f; bool resc = false; unsigned onm_prev = 0xffffffffu;
    f32x16 negm; for (int i = 0; i < 16; ++i) { negm[i] = 0.f; o[0][i] = 0.f; o[1][i] = 0.f; }
    bf16x8 kf[8]; s16x4 vlo[8], vhi[8]; u32x4 pw0, pw1, pw2, pw3;
    f32x16 pA0, pA1, pB0, pB1;
    P_WBN((tq1 >= 0 ? 1 : 0) + 1);
    P_ISSUE();
    { kload8(kf, (lds_cptr)(ring + L_K + s0 * 8192) + kfrag_off(r32, hi));
      pA0 = negm; pA1 = negm;
#pragma unroll
      for (int d0 = 0; d0 < 4; ++d0) { pA0 = MFMA32(kf[2 * d0], qr[d0], pA0); pA1 = MFMA32(kf[2 * d0 + 1], qr[d0], pA1); }
      mask_tile(pA0, pA1, 1, true, ql, hi);
      const float rm = half_swap_max(max32(pA0, pA1)); mref = rm;
#pragma unroll
      for (int r = 0; r < 16; ++r) { pA0[r] = P_EX(pA0[r] - rm); pA1[r] = P_EX(pA1[r] - rm); negm[r] = -rm; }
      asm volatile("" : "+v"(negm)); }
    P_SHIFT();
    if (tq0 < 0) { P_DRAIN(pA0, pA1); }
    else for (;;) {
        P_BODY(pB0, pB1, pA0, pA1); if (tq0 < 0) { P_DRAIN(pB0, pB1); break; }
        P_BODY(pA0, pA1, pB0, pB1); if (tq0 < 0) { P_DRAIN(pA0, pA1); break; }
    }
    l_out = l_reg;
    asm volatile("s_waitcnt lgkmcnt(0)\n\ts_barrier" ::: "memory");
#undef P_SBAR
#undef P_PIN
#undef P_WB
#undef P_WBN
#undef P_PKW
#undef P_PAF
#undef P_VFR
#undef P_GAPA
#undef P_EX
#undef P_GAPB
#undef P_VRD
#undef P_DMAK
#undef P_DMAV
#undef P_ISSUE
#undef P_SHIFT
#undef P_RESC
#undef P_STEP
#undef P_DRAIN
#undef P_BODY
}
__device__ __forceinline__ void fold_branch_lds(LAS float* ocb, const f32x16* o_, float l_, float gate, bool add, int r32, int hi, LAS float* wsf) {
    const float lt = half_swap_sum(l_); const float fac = lt > 0.f ? gate / lt : 0.f;
    if (hi == 0) wsf[r32] = fac;
    LDS_WAIT();
#pragma unroll
    for (int r = 0; r < 16; ++r) { const float f = wsf[crow(r, hi)]; LAS float* p = ocb + crow(r, hi) * 64 + r32;
        if (add) { p[0] += o_[0][r] * f; p[32] += o_[1][r] * f; } else { p[0] = o_[0][r] * f; p[32] = o_[1][r] * f; } }
}
__device__ __forceinline__ float gelu_tanh(float x) { const float u = 0.7978845608028654f * (x + 0.044715f * x * x * x); const float th = 1.f - 2.f / (__expf(2.f * u) + 1.f); return 0.5f * x * (1.f + th); }

__device__ __forceinline__ void compress_pair(int item, const bf16_t* HM, const bf16_t* W1, const bf16_t* W2, const float* b1f, const float* b2, bf16_t* KCV, LAS unsigned char* ring, int wid, int lane) {
    const int kv = item & 1, nt4 = (item >> 1) & 3, bg = item >> 3, b = bg >> 1, g = bg & 1;
    const int r32 = lane & 31, hi = lane >> 5, cb = wid & 3, kh = wid >> 2;
    const int n = 32 * nt4 + r32;
    const bf16_t* abase0 = HM + (size_t)(((kv ? HS_VC : HS_KC) + g) * BATCH + b) * SEQ * 64 + 8 * hi;
    const bf16_t* abase1 = abase0 + (size_t)16 * SEQ * 64;
    const bf16_t* wb = W1 + ((size_t)kv * 128 + 32 * cb + r32) * 2048 + 1024 * kh + 8 * hi;
    f32x16 acc0, acc1; for (int i = 0; i < 16; ++i) { acc0[i] = 0.f; acc1[i] = 0.f; }
#pragma unroll 16
    for (int ks = 0; ks < 64; ++ks) { const int l = 16 * kh + (ks >> 2); int tok = 16 * n + l; tok = tok < SEQ ? tok : SEQ - 1;
        const bf16x8 a0 = *(const bf16x8*)(abase0 + (size_t)tok * 64 + 16 * (ks & 3)), a1 = *(const bf16x8*)(abase1 + (size_t)tok * 64 + 16 * (ks & 3)); const bf16x8 bw = *(const bf16x8*)(wb + 16 * ks);
        acc0 = MFMA32(a0, bw, acc0); acc1 = MFMA32(a1, bw, acc1); }
    LAS float* RED = (LAS float*)ring;
    LAS bf16_t* HID = (LAS bf16_t*)(ring + 2 * 4 * 32 * 33 * 4);
    if (kh == 1) {
#pragma unroll
        for (int i = 0; i < 16; ++i) { RED[(cb * 32 + crow(i, hi)) * 33 + r32] = acc0[i]; RED[4 * 32 * 33 + (cb * 32 + crow(i, hi)) * 33 + r32] = acc1[i]; } }
    __syncthreads();
    if (kh == 0) {
#pragma unroll
        for (int i = 0; i < 16; ++i) { const int row = crow(i, hi), col = 32 * cb + r32; const float bias = b1f[kv * 128 + col];
            const float v0 = acc0[i] + RED[(cb * 32 + row) * 33 + r32] + bias, v1 = acc1[i] + RED[4 * 32 * 33 + (cb * 32 + row) * 33 + r32] + bias;
            HID[row * 136 + col] = (bf16_t)(cvtpk(gelu_tanh(v0), 0.f) & 0xffffu); HID[32 * 136 + row * 136 + col] = (bf16_t)(cvtpk(gelu_tanh(v1), 0.f) & 0xffffu); } }
    __syncthreads();
    if (wid < 4) {
        const int it = wid >> 1, ch = wid & 1;
        f32x16 o; for (int i = 0; i < 16; ++i) o[i] = 0.f;
        const bf16_t* w2b = W2 + ((size_t)kv * 64 + 32 * ch + r32) * 128 + 8 * hi;
#pragma unroll
        for (int ks = 0; ks < 8; ++ks) { const bf16x8 a = *(const LAS bf16x8*)(HID + it * 32 * 136 + r32 * 136 + 16 * ks + 8 * hi); const bf16x8 bw = *(const bf16x8*)(w2b + 16 * ks); o = MFMA32(a, bw, o); }
        bf16_t* dst = KCV + (size_t)kv * (64 * 128 * 64) + (size_t)(bg + 32 * it) * 128 * 64;
#pragma unroll
        for (int i = 0; i < 16; ++i) { const int row = crow(i, hi), col = 32 * ch + r32; dst[(size_t)(32 * nt4 + row) * 64 + col] = (bf16_t)(cvtpk(o[i] + b2[kv * 64 + col], 0.f) & 0xffffu); }
    }
    __syncthreads();
}
}

constexpr int CW_TMO = 0, CW_CODE = 1, CW_BAR = 4096;
struct Args { const float* in[26]; float* out; unsigned char* ws; int ph_lo, ph_hi; };
struct Frame {
    LAS unsigned char* lds; volatile LAS unsigned* MISC; int wave, vcu, G;
};
__device__ __forceinline__ float wave_sum(float v) {
    v += __builtin_bit_cast(float, __builtin_amdgcn_update_dpp(0, __builtin_bit_cast(int, v), 0xB1, 0xf, 0xf, true));
    v += __builtin_bit_cast(float, __builtin_amdgcn_update_dpp(0, __builtin_bit_cast(int, v), 0x4E, 0xf, 0xf, true));
    v += __builtin_bit_cast(float, __builtin_amdgcn_update_dpp(0, __builtin_bit_cast(int, v), 0x141, 0xf, 0xf, true));
    v += __builtin_bit_cast(float, __builtin_amdgcn_update_dpp(0, __builtin_bit_cast(int, v), 0x140, 0xf, 0xf, true));
    { auto rr = __builtin_amdgcn_permlane16_swap(__float_as_uint(v), __float_as_uint(v), false, false); v = __uint_as_float(rr[0]) + __uint_as_float(rr[1]); }
    { auto rr = __builtin_amdgcn_permlane32_swap(__float_as_uint(v), __float_as_uint(v), false, false); v = __uint_as_float(rr[0]) + __uint_as_float(rr[1]); }
    return v;
}

__device__ __forceinline__ void p0_tr_item(const float* W, int K, int N, int nblk, bf16_t* WT, int rmul, int roff, int nscale, float sc, LAS float* scr, int item, int lane, int ldt = 0, int koff = 0, int f8 = 0, int ldw = 0) {
    if (ldt == 0) ldt = K;
    if (ldw == 0) ldw = N;
    const int kb = item / nblk, nb = item % nblk, k0 = 64 * kb, n0 = 32 * nb;
    const int nn = n0 + (lane & 31); const bool ok = nn < N;
    float tv[32];
#pragma unroll
    for (int i = 0; i < 32; ++i) { const int kk = 2 * i + (lane >> 5); tv[i] = ok ? W[(size_t)(k0 + kk) * ldw + nn] : 0.f; }
#pragma unroll
    for (int i = 0; i < 32; ++i) { const int kk = 2 * i + (lane >> 5); scr[kk * 33 + (lane & 31)] = tv[i]; }
    LDS_WAIT(); asm volatile("" ::: "memory");
    const int c = lane & 7;
#pragma unroll
    for (int j = 0; j < 4; ++j) { const int n = (lane >> 3) + 8 * j; const LAS float* s = scr + (8 * c) * 33 + n; const float f = (n0 + n < nscale) ? sc : 1.f;
        u32x4 o; o.x = cvtpk(s[0 * 33] * f, s[1 * 33] * f); o.y = cvtpk(s[2 * 33] * f, s[3 * 33] * f); o.z = cvtpk(s[4 * 33] * f, s[5 * 33] * f); o.w = cvtpk(s[6 * 33] * f, s[7 * 33] * f);
        if (f8) { const float f8s = f * 32.f; u32x2 o8; o8.x = (unsigned)pack4_fp8(s[0 * 33] * f8s, s[1 * 33] * f8s, s[2 * 33] * f8s, s[3 * 33] * f8s); o8.y = (unsigned)pack4_fp8(s[4 * 33] * f8s, s[5 * 33] * f8s, s[6 * 33] * f8s, s[7 * 33] * f8s);
                  *(u32x2*)((unsigned char*)WT + (size_t)(roff + (n0 + n) * rmul) * ldt + k0 + 8 * c) = o8; }
        else *(u32x4*)(WT + (size_t)(roff + (n0 + n) * rmul) * ldt + koff + k0 + 8 * c) = o; }
    LDS_WAIT(); asm volatile("" ::: "memory");
}

__global__ void __launch_bounds__(NWAVES * 64, 2) nsa_fwd(Args args) {
    extern __shared__ __attribute__((aligned(16))) unsigned char lds_raw[];
    Frame F;
    F.lds = (LAS unsigned char*)lds_raw;
    F.MISC = (volatile LAS unsigned*)(F.lds + LDS_MISC);
    F.wave = __builtin_amdgcn_readfirstlane((int)threadIdx.x >> 6);
    F.G = gridDim.x; { const int bx = blockIdx.x; F.vcu = (F.G % 8 == 0) ? (bx % 8) * (F.G / 8) + bx / 8 : bx; }
    unsigned char* ws = args.ws;
    gu32* ctl = (gu32*)(ws + WS_CTL);
    for (int u = threadIdx.x; u < 256; u += NWAVES * 64) ((LAS unsigned*)(F.lds + LDS_MISC))[u] = 0u;
    __syncthreads();
    XcdBarrier bar = xcd_barrier_post((unsigned*)(ctl + CW_BAR), F.MISC + 8);
    const int lo = args.ph_lo, hi = args.ph_hi;
#define IN(k) (lo <= (k) && (k) < hi)
#define SEAM(k) do { if (IN(k) && IN((k) + 1)) xcd_barrier(bar); } while (0)
    LAS unsigned char* ring = F.lds + RING_OFF;
    const int gw = F.vcu * NWAVES + F.wave, NGW = F.G * NWAVES;

    const float* x = args.in[0]; const float* p_in = args.in[1]; const float* w_in = args.in[2];
    const float* conv_w = args.in[8]; const float* ln1_g = args.in[12]; const float* ln1_b = args.in[13];
    const float* rg_w = args.in[14]; const float* rg_b = args.in[15]; const float* re_w = args.in[16]; const float* re_b = args.in[17];
    const float* ple_gate_b = args.in[23]; const float* ln2_g = args.in[24]; const float* ln2_b = args.in[25];
#define Wi8 ((bf16_t*)(ws + WS_WI))
#define Wib ((bf16_t*)(ws + WS_WI + 4 * MiB))
#define XF8 ((unsigned char*)(ws + WS_OV))
#define Wn ((bf16_t*)(ws + WS_WN))
#define Wo ((bf16_t*)(ws + WS_WO))
#define Wpg ((bf16_t*)(ws + WS_WPG))
#define Wpp ((bf16_t*)(ws + WS_WPP))
#define W1 ((bf16_t*)(ws + WS_W1))
#define W2 ((bf16_t*)(ws + WS_W2))
#define Wgu ((bf16_t*)(ws + WS_WGU))
#define Wd ((bf16_t*)(ws + WS_WD))
#define WRH ((bf16_t*)(ws + WS_WRH))
#define WRL ((bf16_t*)(ws + WS_WRL))
#define PB ((bf16_t*)(ws + WS_PB))
#define HM ((bf16_t*)(ws + WS_HM))
#define Z ((bf16_t*)(ws + WS_Z))
#define ZG8 ((unsigned char*)(ws + WS_ZG8))
#define XB ((bf16_t*)(ws + WS_XB))
#define OV ((bf16_t*)(ws + WS_OV))
#define T1 ((bf16_t*)(ws + WS_T1))
#define X1ST ((float*)(ws + WS_X1B))
#define X1F8 ((unsigned char*)(ws + WS_XS))
#define PLEB ((bf16_t*)(ws + WS_PLE))
#define T2F8 ((unsigned char*)(ws + WS_ZG8))
#define YS ((bf16_t*)(ws + WS_YS))
#define HS ((bf16_t*)args.out)
#define H1 ((bf16_t*)args.out + (size_t)64 * 1024 * 1024)
#define b1f ((float*)(ws + WS_B1F))
#define cnt ((unsigned*)(ws + WS_CNT))
#define meta ((unsigned*)(ws + WS_META))
#define perm ((int*)(ws + WS_PERM))
#define route ((unsigned*)(ws + WS_ROUTE))
#define tokslot ((int*)(ws + WS_TOKSLOT))
#define wslot ((float*)(ws + WS_WSLOT))
    const int RPB = (M + F.G - 1) / F.G;

    if (IN(0)) {
        int plane = lane_id(); asm volatile("" : "+v"(plane)); const int ptid = F.wave * 64 + plane; (void)ptid;
        LAS float* scr = (LAS float*)(ring + F.wave * 16384);
        constexpr int I_WI = 16 * 160, I_WN = 8 * 32, I_WO = 16 * 32, I_PP = 4 * 32, I_W1 = 2 * 128, I_W2 = 2 * 4, I_EX = 32 * 128;
        constexpr int NITEMS = I_WI + 2 * I_WN + 2 * I_WO + I_PP + I_W1 + I_W2 + 3 * I_EX;
        for (int it = gw; it < NITEMS; it += NGW) {
            int r = it;
            if (r < 640) { p0_tr_item(w_in, 1024, NHM, 40, Wi8, 1, 0, 512, C2, scr, r, plane, 0, 0, 1, NZ); continue; } r -= 640;
            if (r < 1024) { p0_tr_item(w_in + 2840, 1024, 2048, 64, Wi8, 1, NHM, 0, 1.f, scr, r, plane, 0, 0, 1, NZ); continue; } r -= 1024;
            if (r < 256) { p0_tr_item(w_in + NHM + 24, 1024, 512, 16, Wib, 1, 0, 0, 1.f, scr, r, plane, 0, 0, 0, NZ); continue; } r -= 256;
            if (r < 256) { p0_tr_item(w_in + NHM + 536, 1024, 512, 16, Wib, 2, 512, 0, 1.f, scr, r, plane, 0, 0, 0, NZ); continue; } r -= 256;
            if (r < 256) { p0_tr_item(w_in + NHM + 1048, 1024, 512, 16, Wib, 2, 513, 0, 1.f, scr, r, plane, 0, 0, 0, NZ); continue; } r -= 256;
            if (r < 128) { p0_tr_item(w_in + NHM, 1024, 24, 8, Wi8, 1, NHM + ZGP, 0, 1.f, scr, r, plane, 0, 0, 1, NZ); continue; } r -= 128;
            if (r < I_WN) { p0_tr_item(args.in[9], 512, 1024, 32, Wn, 1, 0, 0, 1.f, scr, r, plane, 1024, 0); continue; } r -= I_WN;
            if (r < I_WN) { p0_tr_item(args.in[10], 512, 1024, 32, Wn, 1, 0, 0, 1.f, scr, r, plane, 1024, 512); continue; } r -= I_WN;
            if (r < I_WO) { p0_tr_item(args.in[11], 1024, 1024, 32, Wo, 1, 0, 0, 1.f, scr, r, plane); continue; } r -= I_WO;
            if (r < I_WO) { p0_tr_item(args.in[22], 1024, 1024, 32, Wpg, 1, 0, 0, 1.f, scr, r, plane, 0, 0, 1); continue; } r -= I_WO;
            if (r < I_PP) { p0_tr_item(args.in[21], 256, 1024, 32, Wpp, 1, 0, 0, 1.f, scr, r, plane); continue; } r -= I_PP;
            if (r < I_W1) { const int kv = r / 128; p0_tr_item(args.in[4] + (size_t)kv * 2048 * 128, 2048, 128, 4, W1 + (size_t)kv * 128 * 2048, 1, 0, 0, 1.f, scr, r % 128, plane); continue; } r -= I_W1;
            if (r < I_W2) { const int kv = r / 4; p0_tr_item(args.in[6] + (size_t)kv * 128 * 64, 128, 64, 2, W2 + (size_t)kv * 64 * 128, 1, 0, 0, 1.f, scr, r % 4, plane); continue; } r -= I_W2;
            if (r < I_EX) { const int e = r / 128; p0_tr_item(args.in[18] + (size_t)e * 1024 * 256, 1024, 256, 8, (bf16_t*)((unsigned char*)Wgu + (size_t)e * 512 * 1024), 2, 0, 0, 1.f, scr, r % 128, plane, 0, 0, 1); continue; } r -= I_EX;
            if (r < I_EX) { const int e = r / 128; p0_tr_item(args.in[19] + (size_t)e * 1024 * 256, 1024, 256, 8, (bf16_t*)((unsigned char*)Wgu + (size_t)e * 512 * 1024), 2, 1, 0, 1.f, scr, r % 128, plane, 0, 0, 1); continue; } r -= I_EX;
            { const int e = r / 128; p0_tr_item(args.in[20] + (size_t)e * 256 * 1024, 256, 1024, 32, (bf16_t*)((unsigned char*)Wd + (size_t)e * 1024 * 256), 1, 0, 0, 1.f, scr, r % 128, plane, 0, 0, 1); }
        }
        for (long ch = (long)gw * 4; ch < (long)M * DM / 512; ch += (long)NGW * 4) { f32x4 a[4], b[4];
#pragma unroll
            for (int u = 0; u < 4; ++u) { const float* sp = x + (ch + u) * 512 + plane * 8; a[u] = __builtin_nontemporal_load((const f32x4*)sp); b[u] = __builtin_nontemporal_load((const f32x4*)(sp + 4)); }
#pragma unroll
            for (int u = 0; u < 4; ++u) { *(u32x4*)(XB + (ch + u) * 512 + plane * 8) = pack8(a[u], b[u]);
                u32x2 o8; o8.x = (unsigned)pack4_fp8(a[u][0], a[u][1], a[u][2], a[u][3]); o8.y = (unsigned)pack4_fp8(b[u][0], b[u][1], b[u][2], b[u][3]); *(u32x2*)(XF8 + (ch + u) * 512 + plane * 8) = o8; } }
        for (long ch = (long)gw * 4; ch < (long)M * PLE / 512; ch += (long)NGW * 4) { f32x4 a[4], b[4];
#pragma unroll
            for (int u = 0; u < 4; ++u) { const float* sp = p_in + (ch + u) * 512 + plane * 8; a[u] = __builtin_nontemporal_load((const f32x4*)sp); b[u] = __builtin_nontemporal_load((const f32x4*)(sp + 4)); }
#pragma unroll
            for (int u = 0; u < 4; ++u) *(u32x4*)(PB + (ch + u) * 512 + plane * 8) = pack8(a[u], b[u]); }
        for (int idx = gw * 64 + plane; idx < 64 * 1024; idx += NGW * 64) { const int c = idx >> 10, k = idx & 1023;
            const float w = c < 32 ? re_w[k * 32 + c] : (c < 36 ? rg_w[k * 4 + (c - 32)] : 0.f);
            const unsigned h = cvtpk(w, 0.f) & 0xffffu; const float wl = w - __uint_as_float(h << 16);
            const int di = (((((k >> 7) * 8 + ((k >> 4) & 7)) * 2 + (c >> 5)) * 64 + ((k >> 3) & 1) * 32 + (c & 31)) << 3) + (k & 7);
            WRH[di] = (bf16_t)h; WRL[di] = (bf16_t)(cvtpk(wl, 0.f) & 0xffffu); }
        for (int o = gw; o < 256; o += NGW) { const int kv = o >> 7, j = o & 127; const float* pe = args.in[3] + kv * 2048; const float* w1 = args.in[4] + (size_t)kv * 2048 * 128;
            float pv_[32], wv_[32];
#pragma unroll
            for (int i = 0; i < 32; ++i) { const int k = plane + 64 * i; pv_[i] = pe[k]; wv_[i] = w1[(size_t)k * 128 + j]; }
            float s = 0.f;
#pragma unroll
            for (int i = 0; i < 32; ++i) s += pv_[i] * wv_[i];
            s = wave_sum(s); if (plane == 0) b1f[o] = s + args.in[5][o]; }
    }
    SEAM(0);

    if (IN(1)) {
        { pg8::Gemm g{(const bf16_t*)XF8, Wi8, DM / 2, DM / 2, DM / 2}; pg8::GridOrder S; S.init(M, NHM + ZGP + 256, F.G, (int)blockIdx.x);
          pg8::EpiInProj8 E{HM, ZG8, Z};
          pg8::gemm_phase<pg8::EpiInProj8, pg8::GridOrder, false, false, true>(ring, g, S, E, F.wave); }
        { pg8::Gemm g{XB, Wib, DM, DM, DM}; pg8::GridOrder S; S.init(M, NZB, F.G, (int)blockIdx.x);
          pg8::EpiInProjZ E{Z};
          pg8::gemm_phase(ring, g, S, E, F.wave); }
    }
    SEAM(1);

    if (IN(2)) {
        int plane = lane_id(); asm volatile("" : "+v"(plane)); const int ptid = F.wave * 64 + plane; (void)ptid;
        for (int item = F.vcu; item < 256; item += F.G) att::compress_pair(item, HM, W1, W2, b1f, args.in[7], (bf16_t*)(ws + WS_KC), ring, F.wave, plane);
        const int c0 = plane * 8;
        f32x4 w0a = *(const f32x4*)(conv_w + c0), w0b = *(const f32x4*)(conv_w + c0 + 4), w1a = *(const f32x4*)(conv_w + 512 + c0), w1b = *(const f32x4*)(conv_w + 512 + c0 + 4),
              w2a = *(const f32x4*)(conv_w + 1024 + c0), w2b = *(const f32x4*)(conv_w + 1024 + c0 + 4);
        for (int ch = gw; ch < M / 32; ch += NGW) {
            const int m0 = ch * 32; const int t0 = m0 % SEQ;
            f32x4 ua1 = {0.f, 0.f, 0.f, 0.f}, ub1 = ua1, ua2 = ua1, ub2 = ua1;
            if (t0 != 0) {
                unpack8(*(const u32x4*)(Z + (size_t)(m0 - 1) * ZP + C_U + c0), ua1, ub1);
                unpack8(*(const u32x4*)(Z + (size_t)(m0 - 2) * ZP + C_U + c0), ua2, ub2);
            }
#pragma unroll 1
            for (int i0 = 0; i0 < 32; i0 += 8) {
                u32x4 ru[8], rb[8];
#pragma unroll
                for (int j = 0; j < 8; ++j) { const size_t zr = (size_t)(m0 + i0 + j) * ZP; ru[j] = *(const u32x4*)(Z + zr + C_U + c0); rb[j] = *(const u32x4*)(Z + zr + C_CB + c0); }
                asm volatile("" ::: "memory");
#pragma unroll
                for (int j = 0; j < 8; ++j) {
                    f32x4 ua, ub, ba, bb; unpack8(ru[j], ua, ub); unpack8(rb[j], ba, bb);
                    const f32x4 ya = ba * (w0a * ua2 + w1a * ua1 + w2a * ua), yb = bb * (w0b * ub2 + w1b * ub1 + w2b * ub);
                    *(u32x4*)(OV + (size_t)(m0 + i0 + j) * DM + 512 + c0) = pack8(ya, yb);
                    ua2 = ua1; ub2 = ub1; ua1 = ua; ub1 = ub;
                }
            }
        }
    }
    SEAM(2);
    if (IN(3)) {
        using namespace att;
        const int wid = F.wave, hh = wid >> 1, qs = wid & 1;
        const unsigned lds0 = (unsigned)(size_t)ring;
        LAS float* IMPG = (LAS float*)(ring + L_IMPG); LAS float* IMPL = (LAS float*)(ring + L_IMPL); LAS float* SC = (LAS float*)(ring + L_SC);
        LAS unsigned* SELM = (LAS unsigned*)(ring + L_SELM); LAS unsigned* UNI = (LAS unsigned*)(ring + L_UNI);
                const int nun = (F.G == 256) ? 8 : (2048 - F.vcu + F.G - 1) / F.G;
        for (int ui = 0; ui < nun; ++ui) {
            unsigned char* ws = args.ws; asm volatile("" : "+s"(ws));
            int bg, qt;
            if (F.G == 256) { bg = F.vcu >> 2; const int s_ = F.vcu & 3; qt = (ui & 1) ? 8 * (ui >> 1) + 7 - s_ : 8 * (ui >> 1) + s_; }
            else { const int u_ = F.vcu + ui * F.G; bg = u_ >> 5; qt = u_ & 31; }
            const int b = bg >> 1, g = bg & 1, head = 4 * g + hh, ntc = (qt >= 16) ? 2 : 1;
            const unsigned upto = (2u << qt) - 1u;
            const bf16_t* hb = HM + (size_t)(g * BATCH + b) * SEQ * 64;
            constexpr size_t HSL = (size_t)BATCH * SEQ * 64;
#define LANE_CTX int lane = lane_id(); const int r32 = lane & 31, hi = lane >> 5, ql = 32 * qs + r32, t = 64 * qt + ql; (void)t; \
            const int vrow_ = 4 * hi + ((lane & 15) >> 2); const unsigned vtr = (unsigned)(vrow_ * 128 + ((((lane >> 4) & 1) ^ (vrow_ & 2)) << 5) + (lane & 3) * 8); (void)vtr; \
            LAS float* wsf = (LAS float*)(ring + L_WSF) + wid * 64; (void)wsf; \
            LAS float* ocb = (LAS float*)(ring + L_IMPG) + wid * 2048; LAS float* gst = (LAS float*)(ring + L_K + 24576) + wid * 256 + lane; (void)gst;
#define LOAD_Q(qv) do { const bf16_t* qp_ = HM + ((size_t)((HS_Q + head) * BATCH + b) * SEQ + t) * 64 + hi * 8; _Pragma("unroll") for (int d0 = 0; d0 < 4; ++d0) qv[d0] = *(const bf16x8*)(qp_ + d0 * 16); } while (0)
            bf16x8 qr[4];
            unsigned uni; int rot = 0;
            {
            LANE_CTX; const int tid_ = wid * 64 + lane; const size_t mrow = (size_t)b * SEQ + t;
            { const bf16_t* kcb = (const bf16_t*)(ws + WS_KC) + (size_t)bg * 128 * 64; const bf16_t* vcb = (const bf16_t*)(ws + WS_VC) + (size_t)bg * 128 * 64;
              dma_kv(kcb, vcb, 0, lds0 + L_K, lds0 + L_V, wid, lane);
              if (ntc == 2) dma_kv(kcb, vcb, 1, lds0 + L_K + 8192, lds0 + L_V + 8192, wid, lane); }
            LOAD_Q(qr);
            const bf16_t* gp = Z + mrow * ZP + C_GN + head * 3;
            const float gate0 = sigm(bflo((unsigned)gp[0]));
            gst[0] = sigm(bflo((unsigned)gp[1])); gst[64] = sigm(bflo((unsigned)gp[2]));
            f32x16 ocomb[2];
            __syncthreads();
            if (tid_ < 64) SELM[tid_] = 0u;
            if (tid_ == 64) UNI[0] = 0u;
            VM_WAIT(); __syncthreads();
            {
                f32x16 a0, a1, b0, b1;
                qkt(a0, a1, ring + L_K, qr, r32, hi);
                if (ntc == 2) qkt(b0, b1, ring + L_K + 8192, qr, r32, hi); else { for (int i = 0; i < 16; ++i) { b0[i] = NEG; b1[i] = NEG; } }
                const int nmax = (t - 31) >> 4;
#pragma unroll
                for (int r = 0; r < 16; ++r) { const int kl = crow(r, hi);
                    a0[r] = (kl > nmax) ? NEG : a0[r]; a1[r] = (kl + 32 > nmax) ? NEG : a1[r]; b0[r] = (kl + 64 > nmax) ? NEG : b0[r]; b1[r] = (kl + 96 > nmax) ? NEG : b1[r]; }
                const float rm = __builtin_fmaxf(rowmax32(a0, a1), rowmax32(b0, b1));
                const bool anyv = nmax >= 0;
                float sum = 0.f;
#pragma unroll
                for (int r = 0; r < 16; ++r) { a0[r] = anyv ? __builtin_amdgcn_exp2f(a0[r] - rm) : 0.f; a1[r] = anyv ? __builtin_amdgcn_exp2f(a1[r] - rm) : 0.f;
                    b0[r] = anyv ? __builtin_amdgcn_exp2f(b0[r] - rm) : 0.f; b1[r] = anyv ? __builtin_amdgcn_exp2f(b1[r] - rm) : 0.f; sum += (a0[r] + a1[r]) + (b0[r] + b1[r]); }
                const float lt = half_swap_sum(sum); const float inv = lt > 0.f ? 1.f / lt : 0.f;
#pragma unroll
                for (int r = 0; r < 16; ++r) { a0[r] *= inv; a1[r] *= inv; b0[r] *= inv; b1[r] *= inv; }
                LAS float* ig = IMPG + (hh * 64 + ql) * 33; LAS float* il = IMPL + (hh * 64 + ql) * 33 + 1;
                if (hi == 0) il[-1] = 0.f;
#pragma unroll
                for (int rg = 0; rg < 4; ++rg) { const int mm = 2 * rg + hi;
                    ig[mm] = (a0[4 * rg] + a0[4 * rg + 1]) + (a0[4 * rg + 2] + a0[4 * rg + 3]); il[mm] = a0[4 * rg + 3];
                    ig[mm + 8] = (a1[4 * rg] + a1[4 * rg + 1]) + (a1[4 * rg + 2] + a1[4 * rg + 3]); il[mm + 8] = a1[4 * rg + 3];
                    ig[mm + 16] = (b0[4 * rg] + b0[4 * rg + 1]) + (b0[4 * rg + 2] + b0[4 * rg + 3]); il[mm + 16] = b0[4 * rg + 3];
                    ig[mm + 24] = (b1[4 * rg] + b1[4 * rg + 1]) + (b1[4 * rg + 2] + b1[4 * rg + 3]); if (mm + 24 < 31) il[mm + 24] = b1[4 * rg + 3]; }
                f32x16 oc[2]; for (int i = 0; i < 16; ++i) { oc[0][i] = 0.f; oc[1][i] = 0.f; }
                pv(oc, lds0 + L_V + vtr, packp(a0, 0), packp(a0, 8), packp(a1, 0), packp(a1, 8));
                if (ntc == 2) pv(oc, lds0 + L_V + 8192 + vtr, packp(b0, 0), packp(b0, 8), packp(b1, 0), packp(b1, 8));
                if (hi == 0) wsf[r32] = gate0;
                LDS_WAIT();
#pragma unroll
                for (int r = 0; r < 16; ++r) { const float f = wsf[crow(r, hi)]; ocomb[0][r] = oc[0][r] * f; ocomb[1][r] = oc[1][r] * f; }
            }
            __syncthreads();
            branch_prologue(hb + HS_KS * HSL, hb + HS_VS * HSL, qt, qt > 0 ? 0 : -1, lds0, wid, lane);
            { const int q = tid_ >> 3, sub = tid_ & 7;
              { const LAS float* pg = IMPG + q * 33 + 4 * sub; const LAS float* pl = IMPL + q * 33 + 4 * sub; f32x4 sv;
#pragma unroll
                for (int e = 0; e < 4; ++e) { const int mm = 4 * sub + e; float imp = 0.f;
#pragma unroll
                    for (int h = 0; h < 4; ++h) imp += pg[h * 64 * 33 + e] + pl[h * 64 * 33 + e];
                    const bool valid = mm <= qt, forced = (mm == 0) || (mm == qt) || (mm == qt - 1);
                    sv[e] = valid ? (imp + (forced ? 1e4f : 0.f)) : -1e4f; }
                *(LAS f32x4*)(SC + q * 36 + 4 * sub) = sv; }
              __syncthreads();
              { f32x4 sc[8];
#pragma unroll
                for (int k = 0; k < 8; ++k) sc[k] = *(const LAS f32x4*)(SC + q * 36 + 4 * k);
                unsigned bits = 0u;
#pragma unroll
                for (int e = 0; e < 4; ++e) { const int mm = 4 * sub + e; const float me_ = SC[q * 36 + mm]; int rank = 0;
#pragma unroll
                    for (int k = 0; k < 32; ++k) { const float o_ = sc[k >> 2][k & 3]; rank += (o_ > me_ || (o_ == me_ && k < mm)) ? 1 : 0; }
                    if (rank < 16) bits |= 1u << mm; }
                atomicOr((unsigned*)&SELM[q], bits); }
              __syncthreads();
              if (tid_ < 64) atomicOr((unsigned*)&UNI[0], SELM[tid_]);
              __syncthreads();
            }
                uni = (unsigned)__builtin_amdgcn_readfirstlane(UNI[0]) & upto;
#pragma unroll
                for (int r = 0; r < 16; ++r) { LAS float* p = ocb + crow(r, hi) * 64 + r32; p[0] = ocomb[0][r]; p[32] = ocomb[1][r]; }
            }
            {
                LANE_CTX; const unsigned selm = SELM[ql]; f32x16 ob[2]; float lb;
                run_branch_pipe<true, true, true>(ob, lb, uni | 1u | (1u << qt), selm, qt, -1, hb + HS_KS * HSL, hb + HS_VS * HSL, ring, lds0, qr, r32, hi, ql, wid, lane, vtr, wsf, rot);
                { int l2 = lane_id(); asm volatile("" : "+v"(l2));
                  fold_branch_lds(ocb, ob, lb, ((LAS float*)(ring + L_K + 24576) + wid * 256 + l2)[0], true, l2 & 31, l2 >> 5, wsf); } }
            {
                LANE_CTX; f32x16 ob[2]; float lb;
                const int j0 = qt >= 8 ? qt - 8 : 0; const unsigned wt = upto & ~((1u << j0) - 1u);
                run_branch_pipe<false, true, false>(ob, lb, wt, 0xffffffffu, qt, qt >= 8 ? qt - 8 : -1, hb + HS_KW * HSL, hb + HS_VW * HSL, ring, lds0, qr, r32, hi, ql, wid, lane, vtr, wsf, rot);
                { int l2 = lane_id(); asm volatile("" : "+v"(l2));
                  fold_branch_lds(ocb, ob, lb, ((LAS float*)(ring + L_K + 24576) + wid * 256 + l2)[64], true, l2 & 31, l2 >> 5, wsf); } }
            {
                LANE_CTX; LDS_WAIT();
                bf16_t* Ow = OV + ((size_t)b * SEQ + 64 * qt + 32 * qs) * DM + head * 64;
#pragma unroll
                for (int i = 0; i < 4; ++i) { const int row = i * 8 + (lane >> 3), ch = lane & 7; const f32x4 va = *(const LAS f32x4*)(ocb + row * 64 + ch * 8), vb_ = *(const LAS f32x4*)(ocb + row * 64 + ch * 8 + 4);
                    *(u32x4*)(Ow + (size_t)row * DM + ch * 8) = pack8(va, vb_); } }
#undef LANE_CTX
#undef LOAD_Q
        }
    }
    SEAM(3);

    if (IN(4)) {
        pg8::Gemm g{OV, Wn, DM, DM, DM}; pg8::GridOrder S; S.init(M, DM, F.G, (int)blockIdx.x);
        pg8::EpiMerge E{T1, ZG8};
        pg8::gemm_phase<pg8::EpiMerge, pg8::GridOrder, false, true>(ring, g, S, E, F.wave);
    }
    SEAM(4);
    if (IN(6)) {
        pg8::Gemm g{T1, Wo, DM, DM, DM}; pg8::GridOrder S; S.init(M, DM, F.G, (int)blockIdx.x);
        pg8::EpiResBf16 E{H1, XB};
        pg8::gemm_phase(ring, g, S, E, F.wave);
    }
    SEAM(6);

    if (IN(7)) {
        int plane = lane_id(); asm volatile("" : "+v"(plane)); const int ptid = F.wave * 64 + plane; (void)ptid;
        constexpr int XROW = 2064;
        LAS unsigned char* XH = ring;
        LAS float* RED = (LAS float*)ring;
        LAS float* LOG = (LAS float*)(ring + 16 * 64 * 33 * 4);
        static_assert(16 * 64 * 33 * 4 + 64 * 36 * 4 <= LDS_BYTES - RING_OFF, "P7 LDS map");
        LAS unsigned* hist = (LAS unsigned*)(F.lds + LDS_MISC + 256);
        if (ptid < 32) hist[ptid] = 0u;
        __syncthreads();
        const int mb = blockIdx.x * RPB, me = (mb + RPB < M) ? mb + RPB : M;
        const int r32 = plane & 31, hi = plane >> 5;
        f32x4 lg[4], lb[4];
#pragma unroll
        for (int j = 0; j < 4; ++j) { const int c = 4 * plane + 256 * j; lg[j] = *(const f32x4*)(ln1_g + c); lb[j] = *(const f32x4*)(ln1_b + c); }
        u32x2 raw[2][4][4];
#define P7_FETCH(mbase) do { _Pragma("unroll") for (int half = 0; half < 2; ++half) _Pragma("unroll") for (int rr = 0; rr < 4; ++rr) { const int m_ = (mbase) + F.wave * 8 + half * 4 + rr; const int mc = m_ < me ? m_ : me - 1; \
            const u32x2* hr = (const u32x2*)(H1 + (size_t)mc * DM) + plane; _Pragma("unroll") for (int j = 0; j < 4; ++j) raw[half][rr][j] = __builtin_nontemporal_load(hr + 64 * j); } } while (0)
        for (int m0 = mb; m0 < me; m0 += 64) {
            P7_FETCH(m0);
#pragma unroll
            for (int half = 0; half < 2; ++half) { f32x4 v[4][4];
#pragma unroll
              for (int rr = 0; rr < 4; ++rr) {
#pragma unroll
                  for (int j = 0; j < 4; ++j) { const u32x2 w = raw[half][rr][j]; v[rr][j] = (f32x4){bflo(w.x), bfhi(w.x), bflo(w.y), bfhi(w.y)}; } }
#pragma unroll
              for (int rr = 0; rr < 4; ++rr) { const int r = F.wave * 8 + half * 4 + rr, m = m0 + r; float s = 0.f;
#pragma unroll
                  for (int j = 0; j < 4; ++j) s += (v[rr][j][0] + v[rr][j][1]) + (v[rr][j][2] + v[rr][j][3]);
                  const float mean = wave_sum(s) * (1.f / DM); float s2 = 0.f;
#pragma unroll
                  for (int j = 0; j < 4; ++j) { v[rr][j] = v[rr][j] - mean; s2 += (v[rr][j][0] * v[rr][j][0] + v[rr][j][1] * v[rr][j][1]) + (v[rr][j][2] * v[rr][j][2] + v[rr][j][3] * v[rr][j][3]); }
                  const float rstd = 1.f / sqrtf(wave_sum(s2) * (1.f / DM) + LN_EPS);
                  if (plane == 0 && m < me) { f32x2 sv; sv[0] = mean; sv[1] = rstd; *(f32x2*)(X1ST + 2 * (size_t)m) = sv; }
#pragma unroll
                  for (int j = 0; j < 4; ++j) { const int c = 4 * plane + 256 * j;
                      const f32x4 y = v[rr][j] * rstd * lg[j] + lb[j];
                      u32x2 wh; wh.x = cvtpk(y[0], y[1]); wh.y = cvtpk(y[2], y[3]);
                      if (m < me) *(int*)(X1F8 + (size_t)m * DM + c) = pack4_fp8(y[0], y[1], y[2], y[3]);
                      *(LAS u32x2*)(XH + r * XROW + c * 2) = wh; } } }
            { att::f32x16 acc[2][2]; for (int i = 0; i < 16; ++i) { acc[0][0][i] = 0.f; acc[0][1][i] = 0.f; acc[1][0][i] = 0.f; acc[1][1][i] = 0.f; }
              int wo_ = F.wave * 8192 + plane * 8; asm volatile("" : "+v"(wo_));
              const bf16_t* wh0 = WRH + wo_; const bf16_t* wl0 = WRL + wo_;
              const LAS unsigned char* xh = XH + r32 * XROW + (128 * F.wave + 8 * hi) * 2;
              bf16x8 wf[4][4];
#pragma unroll
              for (int ks = 0; ks < 4; ++ks) { wf[ks][0] = *(const bf16x8*)(wh0 + ks * 1024); wf[ks][1] = *(const bf16x8*)(wh0 + ks * 1024 + 512); wf[ks][2] = *(const bf16x8*)(wl0 + ks * 1024); wf[ks][3] = *(const bf16x8*)(wl0 + ks * 1024 + 512); }
              asm volatile("" ::: "memory");
              __syncthreads();
#pragma unroll
              for (int kg = 0; kg < 2; ++kg) {
                  if (kg == 1) {
#pragma unroll
                      for (int ks = 0; ks < 4; ++ks) { wf[ks][0] = *(const bf16x8*)(wh0 + (ks + 4) * 1024); wf[ks][1] = *(const bf16x8*)(wh0 + (ks + 4) * 1024 + 512); wf[ks][2] = *(const bf16x8*)(wl0 + (ks + 4) * 1024); wf[ks][3] = *(const bf16x8*)(wl0 + (ks + 4) * 1024 + 512); }
                      asm volatile("" ::: "memory"); }
#pragma unroll
                  for (int k4 = 0; k4 < 4; ++k4) { const int ks = kg * 4 + k4;
                      const bf16x8 a0 = *(const LAS bf16x8*)(xh + ks * 32), a1 = *(const LAS bf16x8*)(xh + 32 * XROW + ks * 32);
                      const bf16x8 bh0 = wf[k4][0], bh1 = wf[k4][1], bl0 = wf[k4][2], bl1 = wf[k4][3];
                      acc[0][0] = MFMA32(a0, bh0, acc[0][0]); acc[0][0] = MFMA32(a0, bl0, acc[0][0]); acc[0][1] = MFMA32(a0, bh1, acc[0][1]); acc[0][1] = MFMA32(a0, bl1, acc[0][1]);
                      acc[1][0] = MFMA32(a1, bh0, acc[1][0]); acc[1][0] = MFMA32(a1, bl0, acc[1][0]); acc[1][1] = MFMA32(a1, bh1, acc[1][1]); acc[1][1] = MFMA32(a1, bl1, acc[1][1]); }
                  asm volatile("" ::: "memory");
              }
              __syncthreads();
#pragma unroll
              for (int rb = 0; rb < 2; ++rb)
#pragma unroll
                  for (int i = 0; i < 16; ++i) { const int row = 32 * rb + att::crow(i, hi); RED[((F.wave * 2 + 0) * 64 + row) * 33 + r32] = acc[rb][0][i]; RED[((F.wave * 2 + 1) * 64 + row) * 33 + r32] = acc[rb][1][i]; }
            }
            __syncthreads();
            { const int r = ptid & 63, og = ptid >> 6;
              for (int o = og; o < 36; o += 8) { const int cb = o >> 5, col = o & 31; float s = 0.f;
#pragma unroll
                  for (int w = 0; w < 8; ++w) s += RED[((w * 2 + cb) * 64 + r) * 33 + col];
                  LOG[r * 36 + o] = s; } }
            __syncthreads();
            if (ptid < 64 && m0 + ptid < me) {
                const int r = ptid, m = m0 + r; const LAS float* lgt = LOG + r * 36;
                float gl[4];
#pragma unroll
                for (int j = 0; j < 4; ++j) gl[j] = lgt[32 + j] + rg_b[j];
                float gmax = gl[0]; int gs = 0;
#pragma unroll
                for (int j = 1; j < 4; ++j) if (gl[j] > gmax) { gmax = gl[j]; gs = j; }
                float gsum = 0.f;
#pragma unroll
                for (int j = 0; j < 4; ++j) gsum += __expf(gl[j] - gmax);
                const float gtop = 1.f / gsum;
                float el[8];
#pragma unroll
                for (int j = 0; j < 8; ++j) el[j] = lgt[gs * 8 + j] + re_b[gs * 8 + j];
                float v0 = el[0]; int i0 = 0;
#pragma unroll
                for (int j = 1; j < 8; ++j) if (el[j] > v0) { v0 = el[j]; i0 = j; }
                float v1 = -3.0e38f; int i1 = 0;
#pragma unroll
                for (int j = 0; j < 8; ++j) if (j != i0 && el[j] > v1) { v1 = el[j]; i1 = j; }
                const float w0 = 1.f / (1.f + __expf(v1 - v0)), w1 = 1.f - w0;
                const unsigned e0 = (unsigned)(gs * 8 + i0), e1 = (unsigned)(gs * 8 + i1);
                const unsigned r0 = atomicAdd((unsigned*)&hist[e0], 1u), r1 = atomicAdd((unsigned*)&hist[e1], 1u);
                u32x4 rw; rw.x = e0 | (e1 << 8); rw.y = r0 | (r1 << 16); rw.z = __float_as_uint(w0 * gtop); rw.w = __float_as_uint(w1 * gtop);
                *(u32x4*)(route + (size_t)m * 4) = rw;
            }
            __syncthreads();
        }
        if (ptid < 32) cnt[blockIdx.x * 32 + ptid] = hist[ptid];
#undef P7_FETCH
    }
    SEAM(7);

    if (IN(8)) {
        int plane = lane_id(); asm volatile("" : "+v"(plane)); const int ptid = F.wave * 64 + plane; (void)ptid;
        LAS unsigned* PT = (LAS unsigned*)ring;
        LAS unsigned* PBf = PT + 512; LAS unsigned* TOT = PT + 1024; LAS unsigned* BEF = PT + 1056; LAS unsigned* SB = PT + 1088;
        { const int e = ptid & 31, part = ptid >> 5; unsigned tot = 0u, bef = 0u;
          unsigned cv_[16];
#pragma unroll
          for (int i = 0; i < 16; ++i) { const int j = part + 16 * i; cv_[i] = j < F.G ? cnt[j * 32 + e] : 0u; }
#pragma unroll
          for (int i = 0; i < 16; ++i) { const int j = part + 16 * i; tot += cv_[i]; if (j < (int)blockIdx.x) bef += cv_[i]; }
          for (int j = part + 256; j < F.G; j += 16) { const unsigned c = cnt[j * 32 + e]; tot += c; if (j < (int)blockIdx.x) bef += c; }
          PT[part * 32 + e] = tot; PBf[part * 32 + e] = bef; }
        __syncthreads();
        if (ptid < 32) { unsigned tot = 0u, bef = 0u;
#pragma unroll
            for (int q = 0; q < 16; ++q) { tot += PT[q * 32 + ptid]; bef += PBf[q * 32 + ptid]; }
            TOT[ptid] = tot; BEF[ptid] = bef; }
        __syncthreads();
        if (ptid < 32) { unsigned base = 0u, tp = 0u;
            for (int e = 0; e < ptid; ++e) { base += TOT[e]; tp += (TOT[e] + 255u) >> 8; }
            SB[ptid] = base + BEF[ptid];
            if (blockIdx.x == 0) { meta[ptid] = base; meta[32 + ptid] = TOT[ptid]; meta[64 + ptid] = tp; if (ptid == 31) meta[96] = tp + ((TOT[31] + 255u) >> 8); } }
        __syncthreads();
        const int mb = blockIdx.x * RPB, me = (mb + RPB < M) ? mb + RPB : M;
        for (int m = mb + ptid; m < me; m += NWAVES * 64) {
            const u32x4 rw = *(const u32x4*)(route + (size_t)m * 4);
            const unsigned s0 = SB[rw.x & 255u] + (rw.y & 0xffffu), s1 = SB[(rw.x >> 8) & 255u] + (rw.y >> 16);
            tokslot[2 * m] = (int)s0; tokslot[2 * m + 1] = (int)s1; wslot[s0] = __uint_as_float(rw.z); wslot[s1] = __uint_as_float(rw.w);
            perm[s0] = m; perm[s1] = m;
        }
        __syncthreads();
    }

    if (IN(9)) {
        pg8::Gemm g{PB, Wpp, PLE, PLE, PLE}; pg8::GridOrder S; S.init(M, DM, F.G, (int)blockIdx.x);
        pg8::EpiStoreFp8 E{T2F8};
        pg8::gemm_phase(ring, g, S, E, F.wave);
    }
    if (IN(10)) {
        pg8::Gemm g{(const bf16_t*)X1F8, Wpg, DM / 2, DM / 2, DM / 2}; pg8::GridOrder S; S.init(M, DM, F.G, (int)blockIdx.x);
        pg8::EpiPle E{PLEB, ple_gate_b, H1, T2F8, X1ST, ln1_g, ln1_b};
        pg8::gemm_phase<pg8::EpiPle, pg8::GridOrder, false, false, true>(ring, g, S, E, F.wave);
    }
    SEAM(10);

    struct MoeOrder {
        const LAS unsigned* mt; int G, c, cts, nb;
        __device__ __forceinline__ bool next(int i, pg8::Unit& u) const {
            const int L = i * G + c; const int tt = L / cts, ct = L % cts; const int TT = (int)mt[96];
            if (tt >= TT) return false;
            int e = 0;
            for (int q = 1; q < 32; ++q) if (tt >= (int)mt[64 + q]) e = q;
            const int rt = tt - (int)mt[64 + e]; const int base = (int)mt[e] + 256 * rt; const int nv = (int)mt[32 + e] - 256 * rt;
            u.arow = __builtin_amdgcn_readfirstlane(base); u.brow = __builtin_amdgcn_readfirstlane(e * nb + 256 * ct); u.orow = u.arow; u.ocol = __builtin_amdgcn_readfirstlane(256 * ct);
            u.nvalid = __builtin_amdgcn_readfirstlane(nv < 256 ? nv : 256); u.idx = i; return true;
        }
    };
    LAS unsigned* MT = (LAS unsigned*)(F.lds + LDS_MISC + 512);
    if (IN(11) || IN(12)) { const int ptid = F.wave * 64 + lane_id(); if (ptid < 97) MT[ptid] = meta[ptid]; __syncthreads(); }
    if (IN(11)) {
        pg8::Gemm g{(const bf16_t*)X1F8, Wgu, DM / 2, DM / 2, DM / 2}; MoeOrder S{MT, F.G, F.vcu, 2, 512};
        LAS unsigned* TAB = (LAS unsigned*)(ring + pg8::STAGE_BYTES);
        LAS float* WTAB = (LAS float*)(TAB + 6 * 256);
        static_assert(pg8::STAGE_BYTES + 2 * 6 * 256 * 4 <= LDS_BYTES - RING_OFF, "P11 LDS tables");
        { pg8::Unit u; const int ptid = F.wave * 64 + lane_id(); unsigned rows_[6]; float wts_[6]; int nu = 0;
#pragma unroll
          for (int i = 0; i < 6; ++i) { rows_[i] = 0u; wts_[i] = 0.f; if (S.next(i, u)) { nu = i + 1; if (ptid < u.nvalid && ptid < 256) { rows_[i] = (unsigned)perm[u.arow + ptid]; wts_[i] = wslot[u.arow + ptid]; } } }
          asm volatile("" ::: "memory");
#pragma unroll
          for (int i = 0; i < 6; ++i) if (i < nu && ptid < 256) { TAB[i * 256 + ptid] = rows_[i] * (unsigned)DM; WTAB[i * 256 + ptid] = wts_[i]; }
          __syncthreads(); }
        pg8::EpiSwiGlu E{(unsigned char*)HS, WTAB};
        pg8::gemm_phase<pg8::EpiSwiGlu, MoeOrder, true, false, true>(ring, g, S, E, F.wave, TAB);
    }
    SEAM(11);
    if (IN(12)) {
        int k12 = EH / 2; asm volatile("" : "+s"(k12));
        pg8::Gemm g{HS, Wd, EH / 2, EH / 2, k12}; MoeOrder S{MT, F.G, F.vcu, 4, 1024};
        pg8::EpiScaleRows E{(unsigned char*)YS};
        pg8::gemm_phase<pg8::EpiScaleRows, MoeOrder, false, false, true>(ring, g, S, E, F.wave);
    }
    SEAM(12);

    if (IN(13)) {
        int plane = lane_id(); asm volatile("" : "+v"(plane)); const int ptid = F.wave * 64 + plane; (void)ptid;
        const bool dead = (__hip_atomic_load(ctl + CW_BAR + XB_TMO, RLX_AGENT) != 0u);
        f32x4 lg[4], lb[4];
#pragma unroll
        for (int j = 0; j < 4; ++j) { const int c = 8 * plane + 512 * (j >> 1) + 4 * (j & 1); lg[j] = *(const f32x4*)(ln2_g + c); lb[j] = *(const f32x4*)(ln2_b + c); }
        int sl_[2][2];
#pragma unroll
        for (int rr = 0; rr < 2; ++rr) { const int m = gw * 2 + rr; sl_[rr][0] = m < M ? tokslot[2 * m] : 0; sl_[rr][1] = m < M ? tokslot[2 * m + 1] : 0; }
        for (int m2 = gw * 2; m2 < M; m2 += NGW * 2) {
            f32x4 v[2][4]; int nx_[2][2];
#pragma unroll
            for (int rr = 0; rr < 2; ++rr) { const int mn = m2 + NGW * 2 + rr; const int mc = mn < M ? mn : M - 1; nx_[rr][0] = tokslot[2 * mc]; nx_[rr][1] = tokslot[2 * mc + 1]; }
#pragma unroll
            for (int rr = 0; rr < 2; ++rr) { const int m = m2 + rr; const int s0 = sl_[rr][0], s1 = sl_[rr][1];
#pragma unroll
                for (int j = 0; j < 2; ++j) { const int c = 8 * plane + 512 * j;
                    f32x4 ya, yb, za, zb, pa, pb;
                    unpack8_fp8(*(const u32x2*)((const unsigned char*)YS + (size_t)s0 * DM + c), ya, yb);
                    unpack8_fp8(*(const u32x2*)((const unsigned char*)YS + (size_t)s1 * DM + c), za, zb); unpack8(*(const u32x4*)(PLEB + (size_t)m * DM + c), pa, pb);
                    v[rr][2 * j] = ya + za + pa; v[rr][2 * j + 1] = yb + zb + pb; } }
#pragma unroll
            for (int rr = 0; rr < 2; ++rr) { const int m = m2 + rr; float s = 0.f;
#pragma unroll
                for (int j = 0; j < 4; ++j) s += (v[rr][j][0] + v[rr][j][1]) + (v[rr][j][2] + v[rr][j][3]);
                const float mean = wave_sum(s) * (1.f / DM); float s2 = 0.f;
#pragma unroll
                for (int j = 0; j < 4; ++j) { v[rr][j] = v[rr][j] - mean; s2 += (v[rr][j][0] * v[rr][j][0] + v[rr][j][1] * v[rr][j][1]) + (v[rr][j][2] * v[rr][j][2] + v[rr][j][3] * v[rr][j][3]); }
                const float rstd = 1.f / sqrtf(wave_sum(s2) * (1.f / DM) + LN_EPS);
#pragma unroll
                for (int j = 0; j < 4; ++j) { const int c = 8 * plane + 512 * (j >> 1) + 4 * (j & 1);
                    f32x4 o = v[rr][j] * rstd * lg[j] + lb[j]; if (dead) { const float q = __builtin_nanf(""); o = (f32x4){q, q, q, q}; }
                    __builtin_nontemporal_store(o, (f32x4*)(args.out + (size_t)m * DM + c)); } }
#pragma unroll
            for (int rr = 0; rr < 2; ++rr) { sl_[rr][0] = nx_[rr][0]; sl_[rr][1] = nx_[rr][1]; }
        }
    }
#undef IN
#undef SEAM
}

#undef T2F8
#undef Wi8
#undef Wib
#undef XF8
#undef Wn
#undef Wo
#undef Wpg
#undef Wpp
#undef W1
#undef W2
#undef Wgu
#undef Wd
#undef WRH
#undef WRL
#undef PB
#undef HM
#undef Z
#undef ZG8
#undef XB
#undef OV
#undef T1
#undef X1ST
#undef X1F8
#undef PLEB
#undef YS
#undef HS
#undef H1
#undef b1f
#undef cnt
#undef meta
#undef perm
#undef route
#undef tokslot
#undef wslot
#ifndef MK_SPLIT
#define MK_SPLIT 0
#endif
constexpr int NPHASE = 14;
extern "C" void kernel_launch(void* const* d_in, const int* in_sizes, int n_in, void* d_out, int out_size, void* d_ws, size_t ws_size, hipStream_t stream) {
    static int grid = 0;
    if (grid == 0) {
        if (n_in != 26 || in_sizes[0] != M * DM || out_size != M * DM || ws_size < WS_END) { fprintf(stderr, "kernel_launch: unexpected shapes (n_in %d, in0 %d, out %d, ws %zu)\n", n_in, n_in > 0 ? in_sizes[0] : -1, out_size, ws_size); grid = -1; return; }
        int dev = 0, cus = 0, per_cu = 0;
        if (hipGetDevice(&dev) != hipSuccess || hipDeviceGetAttribute(&cus, hipDeviceAttributeMultiprocessorCount, dev) != hipSuccess) { grid = -1; return; }
        if (hipFuncSetAttribute((const void*)nsa_fwd, hipFuncAttributeMaxDynamicSharedMemorySize, LDS_BYTES) != hipSuccess) { fprintf(stderr, "kernel_launch: hipFuncSetAttribute failed\n"); grid = -1; return; }
        if (hipOccupancyMaxActiveBlocksPerMultiprocessor(&per_cu, (const void*)nsa_fwd, NWAVES * 64, LDS_BYTES) != hipSuccess || per_cu < 1) { fprintf(stderr, "kernel_launch: occupancy query reports %d\n", per_cu); }
        (void)hipGetLastError();
        grid = cus;
    }
    if (grid < 0) return;
    (void)hipMemsetAsync((char*)d_ws + WS_CTL, 0, CTL_ZERO_BYTES, stream);
    Args a{};
    for (int i = 0; i < 26; ++i) a.in[i] = (const float*)d_in[i];
    a.out = (float*)d_out; a.ws = (unsigned char*)d_ws;
#if MK_SPLIT
    for (int ph = 0; ph < NPHASE; ++ph) { a.ph_lo = ph; a.ph_hi = ph + 1; hipLaunchKernelGGL(nsa_fwd, dim3(grid), dim3(NWAVES * 64), LDS_BYTES, stream, a); }
#else
    a.ph_lo = 0; a.ph_hi = NPHASE;
    hipLaunchKernelGGL(nsa_fwd, dim3(grid), dim3(NWAVES * 64), LDS_BYTES, stream, a);
#endif
}
```
